# Optimizing an MI355X kernel written in HIP

```python
import math
import jax, jax.numpy as jnp
from jax import lax
import numpy as np

D_MODEL = 1024
BATCH = 2
SEQ = 8192
DEPTH = 2

N_MIXERS = 2
N_ATTN_LAYERS = (DEPTH + N_MIXERS - 1) // N_MIXERS
N_FOURIER_LAYERS = DEPTH // N_MIXERS
N_DIFF_HEADS = 8
DIFF_HEAD_DIM = D_MODEL // N_DIFF_HEADS // 2
DIFF_V_DIM = 2 * DIFF_HEAD_DIM
Q_BLOCK = 128
N_FOURIER_GROUPS = 4
FOURIER_GROUP_DIM = D_MODEL // N_FOURIER_GROUPS
N_EXPERT_GROUPS = 4
EXPERTS_PER_GROUP = 4
N_EXPERTS = N_EXPERT_GROUPS * EXPERTS_PER_GROUP
EXPERT_TOP_K = 2
D_EXPERT = D_MODEL // 2
N_ADA = 6
ADA_INIT_SCALE = 0.5
EPS = 1e-6

kernel_name = "hybrid_diffattn_fnet_hmoe_adaln"


def rmsnorm(x, g):
    xf = x.astype(jnp.float32)
    y = xf * lax.rsqrt(jnp.mean(xf * xf, axis=-1, keepdims=True) + EPS)
    return (y * g.astype(jnp.float32)).astype(x.dtype)


def modulate(h, shift, scale):
    return h * (1.0 + scale[:, None, :]) + shift[:, None, :]


def alibi_slopes(n_heads):
    return 2.0 ** (-8.0 * jnp.arange(1, n_heads + 1, dtype=jnp.float32) / n_heads)


def diff_attention(h, w_in, lam_q1, lam_k1, lam_q2, lam_k2, subln_g, w_out, layer_idx):
    B, S, D = h.shape
    H, dh, dv = N_DIFF_HEADS, DIFF_HEAD_DIM, DIFF_V_DIM
    qkv = h @ w_in
    q, k, v = jnp.split(qkv, 3, axis=-1)
    q = q.reshape(B, S, H, 2, dh) * (dh ** -0.5)
    k = k.reshape(B, S, H, 2, dh)
    v = v.reshape(B, S, H, dv)
    q1, q2 = q[..., 0, :], q[..., 1, :]
    k1, k2 = k[..., 0, :], k[..., 1, :]
    lam_init = 0.8 - 0.6 * math.exp(-0.3 * layer_idx)
    lam = (jnp.exp(jnp.sum(lam_q1.astype(jnp.float32) * lam_k1.astype(jnp.float32)))
           - jnp.exp(jnp.sum(lam_q2.astype(jnp.float32) * lam_k2.astype(jnp.float32)))
           + lam_init)
    slopes = alibi_slopes(H)
    pos = jnp.arange(S, dtype=jnp.float32)
    nb = S // Q_BLOCK
    q1b = q1.reshape(B, nb, Q_BLOCK, H, dh).transpose(1, 0, 3, 2, 4)
    q2b = q2.reshape(B, nb, Q_BLOCK, H, dh).transpose(1, 0, 3, 2, 4)
    posb = pos.reshape(nb, Q_BLOCK)

    def block(args):
        qa, qb, pq = args
        bias = -slopes[:, None, None] * jnp.abs(pq[:, None] - pos[None, :])
        s1 = jnp.einsum('bhqd,bkhd->bhqk', qa, k1, preferred_element_type=jnp.float32) + bias
        s2 = jnp.einsum('bhqd,bkhd->bhqk', qb, k2, preferred_element_type=jnp.float32) + bias
        a = jax.nn.softmax(s1, axis=-1) - lam * jax.nn.softmax(s2, axis=-1)
        return jnp.einsum('bhqk,bkhd->bqhd', a.astype(v.dtype), v)

    o = lax.map(block, (q1b, q2b, posb))
    o = o.transpose(1, 0, 2, 3, 4).reshape(B, S, H, dv)
    o = rmsnorm(o, subln_g) * (1.0 - lam_init)
    return o.reshape(B, S, H * dv) @ w_out


def fourier_mix(h, w_in, w_out):
    B, S, D = h.shape
    u = (h @ w_in).reshape(B, S, N_FOURIER_GROUPS, FOURIER_GROUP_DIM).astype(jnp.float32)
    f = jnp.fft.fft2(u, axes=(1, 3), norm="ortho").real
    return f.reshape(B, S, D).astype(h.dtype) @ w_out


def hier_moe(h, w_rg, b_rg, w_re, b_re, w_gate, w_up, w_down):
    B, S, D = h.shape
    t = h.reshape(B * S, D)
    T = t.shape[0]
    g_logits = (t @ w_rg).astype(jnp.float32) + b_rg.astype(jnp.float32)
    g_prob = jax.nn.softmax(g_logits, axis=-1)
    g_idx = jnp.argmax(g_logits, axis=-1)
    g_w = jnp.take_along_axis(g_prob, g_idx[:, None], axis=-1)
    e_logits = jnp.einsum('td,dge->tge', t, w_re).astype(jnp.float32) + b_re.astype(jnp.float32)
    e_sel = jnp.take_along_axis(e_logits, g_idx[:, None, None], axis=1)[:, 0]
    top_v, top_i = lax.top_k(e_sel, EXPERT_TOP_K)
    top_w = jax.nn.softmax(top_v, axis=-1)
    e_w = jnp.sum(jax.nn.one_hot(top_i, EXPERTS_PER_GROUP, dtype=jnp.float32) * top_w[..., None], axis=1)
    gates = (jax.nn.one_hot(g_idx, N_EXPERT_GROUPS, dtype=jnp.float32)[:, :, None]
             * (g_w[:, :, None] * e_w[:, None, :])).reshape(T, N_EXPERTS)
    hid = jax.nn.silu(jnp.einsum('td,edf->tef', t, w_gate)) * jnp.einsum('td,edf->tef', t, w_up)
    hid = hid * gates.astype(hid.dtype)[:, :, None]
    y = jnp.einsum('tef,efd->td', hid, w_down)
    return y.reshape(B, S, D)


def setup_inputs(seed: int = 0) -> dict:
    key = jax.random.key(seed)
    ks = jax.random.split(key, 24)
    D = D_MODEL

    def nrm(k, shape, scale):
        return jax.random.normal(k, shape, jnp.float32) * scale

    return {
        "x": nrm(ks[0], (BATCH, SEQ, D), 1.0),
        "c": nrm(ks[1], (BATCH, D), 1.0),
        "ada_w": nrm(ks[2], (DEPTH, D, N_ADA * D), ADA_INIT_SCALE * D ** -0.5),
        "ada_b": nrm(ks[3], (DEPTH, N_ADA * D), 0.02),
        "norm_mix": 1.0 + nrm(ks[4], (DEPTH, D), 0.02),
        "norm_ffn": 1.0 + nrm(ks[5], (DEPTH, D), 0.02),
        "attn_w_in": nrm(ks[6], (N_ATTN_LAYERS, D, 3 * D), D ** -0.5),
        "attn_lam_q1": nrm(ks[7], (N_ATTN_LAYERS, DIFF_HEAD_DIM), 0.1),
        "attn_lam_k1": nrm(ks[8], (N_ATTN_LAYERS, DIFF_HEAD_DIM), 0.1),
        "attn_lam_q2": nrm(ks[9], (N_ATTN_LAYERS, DIFF_HEAD_DIM), 0.1),
        "attn_lam_k2": nrm(ks[10], (N_ATTN_LAYERS, DIFF_HEAD_DIM), 0.1),
        "attn_subln": 1.0 + nrm(ks[11], (N_ATTN_LAYERS, DIFF_V_DIM), 0.02),
        "attn_w_out": nrm(ks[12], (N_ATTN_LAYERS, N_DIFF_HEADS * DIFF_V_DIM, D), (N_DIFF_HEADS * DIFF_V_DIM) ** -0.5),
        "fourier_w_in": nrm(ks[13], (N_FOURIER_LAYERS, D, D), D ** -0.5),
        "fourier_w_out": nrm(ks[14], (N_FOURIER_LAYERS, D, D), D ** -0.5),
        "router_group_w": nrm(ks[15], (DEPTH, D, N_EXPERT_GROUPS), D ** -0.5),
        "router_group_b": nrm(ks[16], (DEPTH, N_EXPERT_GROUPS), 0.01),
        "router_expert_w": nrm(ks[17], (DEPTH, D, N_EXPERT_GROUPS, EXPERTS_PER_GROUP), D ** -0.5),
        "router_expert_b": nrm(ks[18], (DEPTH, N_EXPERT_GROUPS, EXPERTS_PER_GROUP), 0.01),
        "expert_w_gate": nrm(ks[19], (DEPTH, N_EXPERTS, D, D_EXPERT), D ** -0.5),
        "expert_w_up": nrm(ks[20], (DEPTH, N_EXPERTS, D, D_EXPERT), D ** -0.5),
        "expert_w_down": nrm(ks[21], (DEPTH, N_EXPERTS, D_EXPERT, D), D_EXPERT ** -0.5),
        "norm_final": 1.0 + nrm(ks[22], (D,), 0.02),
    }


def reference(x, c, ada_w, ada_b, norm_mix, norm_ffn, attn_w_in, attn_lam_q1, attn_lam_k1,
              attn_lam_q2, attn_lam_k2, attn_subln, attn_w_out, fourier_w_in, fourier_w_out,
              router_group_w, router_group_b, router_expert_w, router_expert_b,
              expert_w_gate, expert_w_up, expert_w_down, norm_final):
    cond = jax.nn.silu(c)
    for i in range(DEPTH):
        mod = cond @ ada_w[i] + ada_b[i]
        sh1, sc1, g1, sh2, sc2, g2 = jnp.split(mod, N_ADA, axis=-1)
        h = modulate(rmsnorm(x, norm_mix[i]), sh1, sc1)
        j = i // N_MIXERS
        if i % N_MIXERS == 0:
            y = diff_attention(h, attn_w_in[j], attn_lam_q1[j], attn_lam_k1[j], attn_lam_q2[j],
                               attn_lam_k2[j], attn_subln[j], attn_w_out[j], i)
        else:
            y = fourier_mix(h, fourier_w_in[j], fourier_w_out[j])
        x = x + g1[:, None, :] * y
        h = modulate(rmsnorm(x, norm_ffn[i]), sh2, sc2)
        y = hier_moe(h, router_group_w[i], router_group_b[i], router_expert_w[i], router_expert_b[i],
                     expert_w_gate[i], expert_w_up[i], expert_w_down[i])
        x = x + g2[:, None, :] * y
    return rmsnorm(x, norm_final)
```

```cpp
#include <hip/hip_runtime.h>
#include <cstdio>
#include <cstdint>

#define LAS __attribute__((address_space(3)))
#define GAS __attribute__((address_space(1)))
typedef unsigned short bf16_t;
typedef short bf16x8 __attribute__((ext_vector_type(8)));
typedef short s16x4 __attribute__((ext_vector_type(4)));
typedef float f32x4 __attribute__((ext_vector_type(4)));
typedef float f32x2 __attribute__((ext_vector_type(2)));
typedef float f32x16 __attribute__((ext_vector_type(16)));
typedef unsigned u32x4 __attribute__((ext_vector_type(4)));
typedef unsigned u32x2 __attribute__((ext_vector_type(2)));
typedef GAS unsigned gu32;

constexpr int NB = 2, SEQ = 8192, DM = 1024, TOK = NB * SEQ;
constexpr int NHEAD = 8, DH = 64, DV = 128;
constexpr int NEXP = 16, DEXP = 512, NBUCKET = 24;
constexpr int NWAVES = 8, NTHREADS = 512;
constexpr float EPS = 1e-6f;
constexpr float LOG2E = 1.4426950408889634f;

__device__ __forceinline__ unsigned f2bf(float f) { unsigned u = __builtin_bit_cast(unsigned, f); return (u + 0x7fffu + ((u >> 16) & 1u)) >> 16; }
__device__ __forceinline__ unsigned pk2(float lo, float hi) { return f2bf(lo) | (f2bf(hi) << 16); }
__device__ __forceinline__ float bf2f(unsigned short h) { return __builtin_bit_cast(float, (unsigned)h << 16); }
__device__ __forceinline__ unsigned cvt_pk_bf16(float lo, float hi) { unsigned r; asm volatile("v_cvt_pk_bf16_f32 %0, %1, %2" : "=v"(r) : "v"(lo), "v"(hi)); return r; }
__device__ __forceinline__ float wave_sum(float v) {
#pragma unroll
    for (int o = 1; o < 64; o <<= 1) v += __shfl_xor(v, o);
    return v;
}

namespace pg8 {
constexpr int BM = 256, BK = 64, HALF = 128, HTB = HALF * BK * 2, STAGE_BYTES = 8 * HTB, NXCD = 8;
__host__ __device__ __forceinline__ int lds_byte(int r, int c) { const int st = (r >> 4) * 2 + (c >> 5), rr = r & 15, cc = c & 31, ob = rr * 64 + cc * 2; return st * 1024 + (ob ^ (((ob >> 9) & 1) << 5)); }
__host__ __device__ __forceinline__ void stage_rc(int b, int& R, int& C) { const int st = b / 1024, sb = b % 1024, swz = sb ^ (((sb >> 9) & 1) << 5); R = (st >> 1) * 16 + swz / 64; C = (st & 1) * 32 + (swz % 64) / 2; }
__host__ __device__ __forceinline__ int perm32(int rho) { const int n = rho >> 4, i = rho & 15; return 8 * (i >> 2) + 4 * n + (i & 3); }

struct Unit { int pm, pn; const char* a; const char* b; int jt; int jb; int aux0, aux1; };

template <class Epi, class Sched, bool GATHER>
__device__ __forceinline__ void gemm_phase(LAS unsigned char* lds, const int K, const int lda, const int ldb, const Sched& S, const Epi& E) {
    int tid = threadIdx.x; asm volatile("" : "+v"(tid));
    const int wid = __builtin_amdgcn_readfirstlane(tid >> 6), lane = tid & 63, wr = wid >> 2, wc = wid & 3, fr = lane & 15, fq = lane >> 4;
    const int nt = K / BK;
    int RA[2], CA[2];
    unsigned voffB[2], vA[2][2], nvA[2][2];
#pragma unroll
    for (int i = 0; i < 2; ++i) { int R, C; stage_rc(tid * 16 + i * 8192, R, C); const int Rb = Epi::PERM ? ((R & ~31) + perm32(R & 31)) : R;
        RA[i] = R; CA[i] = C; voffB[i] = (unsigned)(Rb * ldb + C) * 2u; }
    const size_t kstep = (size_t)(BK * 2);
    const size_t hstepB = (size_t)HALF * ldb * 2;
    const unsigned ldsw = (unsigned)wid * 1024u;
    const int aoff = lds_byte(wr * 64 + fr, fq * 8), boff = lds_byte(wc * 32 + fr, fq * 8);
#define PG8_SA(b, h) (((b) * 2 + (h)) * HTB)
#define PG8_SB(b, h) ((4 + (b) * 2 + (h)) * HTB)
#define PG8_STAGE(bufoff, gbase, voff) do { _Pragma("unroll") for (int _i = 0; _i < 2; ++_i) \
        __builtin_amdgcn_global_load_lds((const unsigned*)((const char*)(gbase) + (voff)[_i]), (LAS unsigned*)(lds + (bufoff) + ldsw + _i * 8192), 16, 0, 0); } while (0)
#define PG8_LDA(dst, b, h) do { _Pragma("unroll") for (int m = 0; m < 4; ++m) _Pragma("unroll") for (int k = 0; k < 2; ++k) dst[m][k] = *(const LAS bf16x8*)(lds + PG8_SA(b, h) + aoff + m * 2048 + k * 1024); } while (0)
#define PG8_LDB(dst, b, h) do { _Pragma("unroll") for (int n = 0; n < 2; ++n) _Pragma("unroll") for (int k = 0; k < 2; ++k) dst[n][k] = *(const LAS bf16x8*)(lds + PG8_SB(b, h) + boff + n * 2048 + k * 1024); } while (0)
#define PG8_MMA(ai, bj, At, Bt) do { __builtin_amdgcn_s_setprio(1); _Pragma("unroll") for (int m = 0; m < 4; ++m) _Pragma("unroll") for (int n = 0; n < 2; ++n) _Pragma("unroll") for (int k = 0; k < 2; ++k) \
        acc[ai][bj][m][n] = __builtin_amdgcn_mfma_f32_16x16x32_bf16(Bt[n][k], At[m][k], acc[ai][bj][m][n], 0, 0, 0); __builtin_amdgcn_s_setprio(0); } while (0)
#define PG8_WAIT_V(n) asm volatile("s_waitcnt vmcnt(" #n ")" ::: "memory")
#define PG8_WAIT_L(n) asm volatile("s_waitcnt lgkmcnt(" #n ")" ::: "memory")
#define PG8_BAR __builtin_amdgcn_s_barrier()
#define PG8_SCHED __builtin_amdgcn_sched_barrier(0)
#define PG8_SETVA(dst, u) do { _Pragma("unroll") for (int _h = 0; _h < 2; ++_h) _Pragma("unroll") for (int _i = 0; _i < 2; ++_i) { \
        if constexpr (GATHER) dst[_h][_i] = (unsigned)(S.arow(u, _h * HALF + RA[_i]) * (unsigned)lda + (unsigned)CA[_i]) * 2u; \
        else dst[_h][_i] = (unsigned)((_h * HALF + RA[_i]) * lda + CA[_i]) * 2u; } } while (0)
    Unit cur, nxt; int ui = 0;
    if (!S.next(0, cur)) return;
    PG8_SETVA(vA, cur);
#pragma unroll
    for (int h = 0; h < 2; ++h)
#pragma unroll
        for (int i = 0; i < 2; ++i) nvA[h][i] = vA[h][i];
    f32x4 acc[2][2][4][2];
#pragma unroll
    for (int a = 0; a < 2; ++a)
#pragma unroll
        for (int b = 0; b < 2; ++b)
#pragma unroll
            for (int m = 0; m < 4; ++m)
#pragma unroll
                for (int n = 0; n < 2; ++n) acc[a][b][m][n] = (f32x4){0.f, 0.f, 0.f, 0.f};
    bf16x8 At[4][2], B0[2][2], B1[2][2];
    const char* cA = cur.a; const char* cB = cur.b;
    PG8_STAGE(PG8_SB(0, 0), cB, voffB); PG8_STAGE(PG8_SB(0, 1), cB + hstepB, voffB); PG8_STAGE(PG8_SA(0, 0), cA, vA[0]); PG8_STAGE(PG8_SA(0, 1), cA, vA[1]);
    if (wr == 1) PG8_BAR;
    PG8_WAIT_V(2); PG8_BAR;
    PG8_STAGE(PG8_SB(1, 0), cB + kstep, voffB); PG8_STAGE(PG8_SA(1, 0), cA + kstep, vA[0]); PG8_STAGE(PG8_SB(1, 1), cB + hstepB + kstep, voffB);
    PG8_WAIT_V(6); PG8_BAR;
    for (;;) {
        const bool has_next = S.next(ui + 1, nxt);
        const char* nA = has_next ? nxt.a : cA; const char* nB = has_next ? nxt.b : cB;
        if constexpr (GATHER) { if (has_next) PG8_SETVA(nvA, nxt); }
        const int jt = cur.jt; const long jb = (long)cur.jb;
        for (int t = 0; t < nt; t += 2) {
            const bool last = (t == nt - 2);
            const char* a1 = cA + (size_t)(t + 1) * kstep;
            const char* a2 = last ? nA : cA + (size_t)(t + 2) * kstep;
            const char* b2 = last ? nB : cB + (size_t)(t + 2) * kstep + ((t + 2) >= jt ? jb : 0l);
            const char* a3 = a2 + kstep;
            const char* b3 = last ? nB + kstep : cB + (size_t)(t + 3) * kstep + ((t + 3) >= jt ? jb : 0l);
            unsigned w0[2], w1[2];
            if constexpr (GATHER) { w0[0] = last ? nvA[0][0] : vA[0][0]; w0[1] = last ? nvA[0][1] : vA[0][1]; w1[0] = last ? nvA[1][0] : vA[1][0]; w1[1] = last ? nvA[1][1] : vA[1][1]; }
            else { w0[0] = vA[0][0]; w0[1] = vA[0][1]; w1[0] = vA[1][0]; w1[1] = vA[1][1]; }
            PG8_LDB(B0, 0, 0); PG8_LDB(B1, 0, 1); PG8_SCHED; PG8_LDA(At, 0, 0); PG8_STAGE(PG8_SA(1, 1), a1, vA[1]);
            PG8_WAIT_V(8); PG8_WAIT_L(0); PG8_BAR; PG8_MMA(0, 0, At, B0); PG8_MMA(0, 1, At, B1); PG8_BAR; PG8_SCHED;
            PG8_LDA(At, 0, 1); PG8_STAGE(PG8_SB(0, 0), b2, voffB); PG8_STAGE(PG8_SB(0, 1), b2 + hstepB, voffB); PG8_STAGE(PG8_SA(0, 0), a2, w0);
            PG8_WAIT_V(8); PG8_WAIT_L(0); PG8_BAR; PG8_MMA(1, 0, At, B0); PG8_MMA(1, 1, At, B1); PG8_BAR; PG8_SCHED;
            PG8_LDB(B0, 1, 0); PG8_LDB(B1, 1, 1); PG8_SCHED; PG8_LDA(At, 1, 0); PG8_STAGE(PG8_SA(0, 1), a2, w1);
            PG8_WAIT_V(8); PG8_WAIT_L(0); PG8_BAR; PG8_MMA(0, 0, At, B0); PG8_MMA(0, 1, At, B1); PG8_BAR; PG8_SCHED;
            PG8_LDA(At, 1, 1); PG8_STAGE(PG8_SB(1, 0), b3, voffB); PG8_STAGE(PG8_SB(1, 1), b3 + hstepB, voffB); PG8_STAGE(PG8_SA(1, 0), a3, w0);
            PG8_WAIT_V(8); PG8_WAIT_L(0); PG8_BAR; PG8_MMA(1, 0, At, B0); PG8_MMA(1, 1, At, B1); PG8_BAR; PG8_SCHED;
        }
        if (wr == 0) PG8_BAR;
        E(acc, cur, wr, wc, fr, fq);
        if (!has_next) break;
#pragma unroll
        for (int a = 0; a < 2; ++a)
#pragma unroll
            for (int b = 0; b < 2; ++b)
#pragma unroll
                for (int m = 0; m < 4; ++m)
#pragma unroll
                    for (int n = 0; n < 2; ++n) acc[a][b][m][n] = (f32x4){0.f, 0.f, 0.f, 0.f};
        cur = nxt; cA = nA; cB = nB; ++ui;
        if constexpr (GATHER) {
#pragma unroll
            for (int h = 0; h < 2; ++h)
#pragma unroll
                for (int i = 0; i < 2; ++i) vA[h][i] = nvA[h][i];
        }
        if (wr == 1) PG8_BAR;
    }
    PG8_WAIT_V(0);
    PG8_BAR;
#undef PG8_SA
#undef PG8_SB
#undef PG8_STAGE
#undef PG8_LDA
#undef PG8_LDB
#undef PG8_MMA
#undef PG8_WAIT_V
#undef PG8_WAIT_L
#undef PG8_BAR
#undef PG8_SCHED
#undef PG8_SETVA
}
}

constexpr size_t MiB = 1u << 20;
constexpr size_t WS_CTL = 0, CTL_ZERO_BYTES = 1 * MiB;
constexpr size_t WS_MISC = 1 * MiB;
constexpr size_t WS_WQKV = 4 * MiB;
constexpr size_t WS_WO   = 10 * MiB;
constexpr size_t WS_WFI  = 12 * MiB;
constexpr size_t WS_WFO  = 16 * MiB;
constexpr size_t WS_WGU  = 18 * MiB;
constexpr size_t WS_WD   = 82 * MiB;
constexpr size_t WS_X    = 114 * MiB;
constexpr size_t WS_H    = 178 * MiB;
constexpr size_t WS_R    = 210 * MiB;
constexpr size_t WS_Q = WS_R, WS_K = WS_R + 32 * MiB, WS_V = WS_R + 64 * MiB;
constexpr size_t WS_HID = WS_R;
constexpr size_t WS_ZT = WS_R;
constexpr size_t WS_FT = WS_R + 64 * MiB;
constexpr size_t WS_END = 306 * MiB;
constexpr size_t MS_MOD = 0;
constexpr size_t MS_TW  = 128 * 1024;
constexpr size_t MS_RW  = 256 * 1024;
constexpr size_t WS_LIST = 2 * MiB;
constexpr int CW_TMO = 0;
constexpr int CW_CNT = 64;
constexpr int CW_BAR = 8192;

constexpr int RING_BYTES = 131072;
constexpr int LDSCTL_OFF = RING_BYTES, MISC_OFF = LDSCTL_OFF + 320;
constexpr int LDS_BYTES = 147456;

#define RLX_AGENT __ATOMIC_RELAXED, __HIP_MEMORY_SCOPE_AGENT
#define LDS_WAIT() asm volatile("s_waitcnt lgkmcnt(0)" ::: "memory")
#define VM_WAIT() asm volatile("s_waitcnt vmcnt(0)" ::: "memory")

#define XB_TMO      128
#define XB_XCNT(j)  (256  + 64 * (j))
#define XB_XSUB(j)  (1280 + 64 * (j))
#define XB_XGEN(j)  (2304 + 64 * (j))
#define XB_TOP      3328
#define XB_TOPGEN   3392
#define XCD_BAR_WORDS 3456
#define XB_SPIN_CAP (1u << 22)
__device__ __forceinline__ unsigned xb_ld(unsigned* p)              { return __hip_atomic_load(p, __ATOMIC_RELAXED, __HIP_MEMORY_SCOPE_AGENT); }
__device__ __forceinline__ unsigned xb_add(unsigned* p, unsigned v) { return __hip_atomic_fetch_add(p, v, __ATOMIC_RELAXED, __HIP_MEMORY_SCOPE_AGENT); }
__device__ __forceinline__ unsigned xb_xcc_id() { return (unsigned)__builtin_amdgcn_s_getreg((3 << 11) | 20) & 0xFu; }
#define XB_SPIN(cond, bar) do { unsigned _sp = 0; while (cond) { __builtin_amdgcn_s_sleep(1); \
    if ((++_sp & 255u) == 0u) { if (xb_ld(&(bar)[XB_TMO])) break; if (_sp > XB_SPIN_CAP) { atomicAdd(&(bar)[XB_TMO], 1u); break; } } } } while (0)
struct XcdBarrier { unsigned* bar; unsigned x; volatile LAS unsigned* st; };
__device__ __forceinline__ XcdBarrier xcd_barrier_post(unsigned* bar, volatile LAS unsigned* st) {
    XcdBarrier b; b.bar = bar; b.x = xb_xcc_id(); b.st = st;
    if (threadIdx.x == 0) (void)xb_add(&bar[XB_XCNT(b.x)], 1u);
    return b;
}
__device__ __forceinline__ void xcd_barrier_complete(unsigned* bar, unsigned x, unsigned& nloc, unsigned& nx) {
    const unsigned G = gridDim.x * gridDim.y * gridDim.z;
    unsigned sum, cnt, mine, sp = 0u;
    for (;;) {
        sum = 0u; cnt = 0u; mine = 0u;
#pragma unroll
        for (unsigned j = 0; j < 16; ++j) { const unsigned c = xb_ld(&bar[XB_XCNT(j)]); sum += c; cnt += (c > 0u) ? 1u : 0u; mine = (j == x) ? c : mine; }
        if (sum == G) break;
        __builtin_amdgcn_s_sleep(1);
        if ((++sp & 255u) == 0u) { if (xb_ld(&bar[XB_TMO])) break; if (sp > XB_SPIN_CAP) { atomicAdd(&bar[XB_TMO], 1u); break; } }
    }
    nloc = mine > 0u ? mine : 1u; nx = cnt > 0u ? cnt : 1u;
}
__device__ __forceinline__ void xcd_barrier(const XcdBarrier& b) {
    asm volatile("s_waitcnt vmcnt(0)" ::: "memory");
    __syncthreads();
    if (threadIdx.x == 0) {
        unsigned* bar = b.bar;
        __builtin_amdgcn_s_waitcnt(0);
        unsigned nloc = b.st[0], nx = b.st[1];
        if (nloc == 0u) { xcd_barrier_complete(bar, b.x, nloc, nx); b.st[0] = nloc; b.st[1] = nx; }
        const unsigned old = xb_add(&bar[XB_XSUB(b.x)], 1u);
        const unsigned gen = old / nloc;
        if (old + 1u == (gen + 1u) * nloc) {
            __builtin_amdgcn_fence(__ATOMIC_RELEASE, "agent");
            asm volatile("s_waitcnt vmcnt(0)" ::: "memory");
            const unsigned og = xb_add(&bar[XB_TOP], 1u);
            const unsigned tg = og / nx;
            if (og + 1u == (tg + 1u) * nx) xb_add(&bar[XB_TOPGEN], 1u);
            else XB_SPIN(xb_ld(&bar[XB_TOPGEN]) == tg, bar);
            __builtin_amdgcn_fence(__ATOMIC_ACQUIRE, "agent");
            xb_add(&bar[XB_XGEN(b.x)], 1u);
            asm volatile("s_waitcnt vmcnt(0)" ::: "memory");
        } else {
            XB_SPIN(xb_ld(&bar[XB_XGEN(b.x)]) == gen, bar);
            __builtin_amdgcn_fence(__ATOMIC_ACQUIRE, "agent");
            asm volatile("s_waitcnt vmcnt(0)" ::: "memory");
        }
    }
    __syncthreads();
}

struct Args {
    const float* in[23];
    float* out; unsigned char* ws;
    int ph_lo, ph_hi;
};
enum InIdx { I_X = 0, I_C, I_ADAW, I_ADAB, I_NMIX, I_NFFN, I_AWIN, I_LQ1, I_LK1, I_LQ2, I_LK2, I_SUBLN, I_AWOUT, I_FWIN, I_FWOUT, I_RGW, I_RGB, I_REW, I_REB, I_EWG, I_EWU, I_EWD, I_NFIN };

struct Frame {
    LAS unsigned char* lds;
    gu32* ctl;
    int tid, lane, wave, vcu, G;
    unsigned char* ws;
};

__device__ __forceinline__ void tr_item(const float* W, int ldw, int k0, int n0, bf16_t* WT, int ldt, int r0, int c0, LAS float* scr, int lane) {
#pragma unroll 8
    for (int i = 0; i < 32; ++i) { const int kk = 2 * i + (lane >> 5); scr[kk * 33 + (lane & 31)] = W[(size_t)(k0 + kk) * ldw + n0 + (lane & 31)]; }
    LDS_WAIT(); asm volatile("" ::: "memory");
    const int c = lane & 7;
#pragma unroll
    for (int j = 0; j < 4; ++j) { const int n = (lane >> 3) + 8 * j; const LAS float* s = scr + (8 * c) * 33 + n;
        u32x4 o; o.x = pk2(s[0 * 33], s[1 * 33]); o.y = pk2(s[2 * 33], s[3 * 33]); o.z = pk2(s[4 * 33], s[5 * 33]); o.w = pk2(s[6 * 33], s[7 * 33]);
        *(GAS u32x4*)(WT + (size_t)(r0 + n) * ldt + c0 + 8 * c) = o; }
    LDS_WAIT(); asm volatile("" ::: "memory");
}
__device__ __forceinline__ void fold_item(const float* win, bf16_t* WT, int item, LAS float* scr, const LAS float* tab, int lane) {
    const int nb = item >> 5, kb = item & 31, n0 = nb * 32, k0 = kb * 32;
    const int part = n0 >> 10, g = (n0 >> 8) & 3, l0 = n0 & 255;
    const LAS float* tb = tab + part * 256;
    LAS float* wt = scr; LAS float* tt = scr + 1152;
    const int kq = lane >> 3, lq = lane & 7;
    f32x4 acc[4];
#pragma unroll
    for (int i = 0; i < 4; ++i) acc[i] = (f32x4){0.f, 0.f, 0.f, 0.f};
    for (int c0 = 0; c0 < 256; c0 += 32) {
#pragma unroll 4
        for (int i = 0; i < 16; ++i) { const int kk = 2 * i + (lane >> 5), cc = lane & 31; wt[cc * 36 + kk] = win[(size_t)(k0 + kk) * 1024 + g * 256 + c0 + cc]; }
#pragma unroll 4
        for (int i = 0; i < 16; ++i) { const int cc = 2 * i + (lane >> 5), l = lane & 31; tt[cc * 36 + l] = tb[((l0 + l) * (c0 + cc)) & 255]; }
        LDS_WAIT(); asm volatile("" ::: "memory");
#pragma unroll 8
        for (int cc = 0; cc < 32; ++cc) { const f32x4 w = *(const LAS f32x4*)(wt + cc * 36 + 4 * kq); const f32x4 t = *(const LAS f32x4*)(tt + cc * 36 + 4 * lq);
            acc[0] += t * w.x; acc[1] += t * w.y; acc[2] += t * w.z; acc[3] += t * w.w; }
        LDS_WAIT(); asm volatile("" ::: "memory");
    }
#pragma unroll
    for (int i = 0; i < 4; ++i)
#pragma unroll
        for (int j = 0; j < 4; ++j) wt[(4 * lq + j) * 36 + 4 * kq + i] = acc[i][j] * 0.0625f;
    LDS_WAIT(); asm volatile("" ::: "memory");
    { const int n = lane >> 1, kh = (lane & 1) * 16; const LAS float* s = wt + n * 36 + kh;
      u32x4 o0, o1; o0.x = pk2(s[0], s[1]); o0.y = pk2(s[2], s[3]); o0.z = pk2(s[4], s[5]); o0.w = pk2(s[6], s[7]); o1.x = pk2(s[8], s[9]); o1.y = pk2(s[10], s[11]); o1.z = pk2(s[12], s[13]); o1.w = pk2(s[14], s[15]);
      GAS u32x4* d = (GAS u32x4*)(WT + (size_t)(n0 + n) * 1024 + k0 + kh); d[0] = o0; d[1] = o1; }
    LDS_WAIT(); asm volatile("" ::: "memory");
}

__device__ __forceinline__ void p0_prologue(Frame& F, const Args& A) {
    unsigned char* ws = F.ws;
    float* mod = (float*)(ws + WS_MISC + MS_MOD);
    LAS float* silu_c = (LAS float*)(F.lds + 112 * 1024);
    LAS float* tab = (LAS float*)(F.lds + 120 * 1024);
    LAS float* part = (LAS float*)(F.lds + 124 * 1024);
    { const int gid = blockIdx.x * NTHREADS + F.tid; if (gid < 8192) { float sv, cv; sincospif((float)gid * (1.0f / 4096.0f), &sv, &cv); float* tw = (float*)(ws + WS_MISC + MS_TW); tw[gid] = cv; tw[8192 + gid] = sv; } }
    if (F.tid < 256) { float sv, cv; sincospif((float)F.tid * (1.0f / 128.0f), &sv, &cv); tab[F.tid] = cv; tab[256 + F.tid] = sv; }
    for (int i = F.tid; i < 2048; i += NTHREADS) { const float v = A.in[I_C][i]; silu_c[i] = v / (1.f + __expf(-v)); }
    __syncthreads();
    for (int item = blockIdx.x; item < 192; item += F.G) {
        const int l = item / 96, cb = item % 96;
        const float* W = A.in[I_ADAW] + (size_t)l * 1024 * 6144 + cb * 64;
        const int cg = F.lane & 15, rs = F.lane >> 4;
        f32x4 a0 = (f32x4){0.f, 0.f, 0.f, 0.f}, a1 = a0;
#pragma unroll 8
        for (int i = 0; i < 32; ++i) { const int row = F.wave * 128 + i * 4 + rs; const f32x4 w = *(const f32x4*)(W + (size_t)row * 6144 + cg * 4); a0 += w * silu_c[row]; a1 += w * silu_c[1024 + row]; }
#pragma unroll
        for (int j = 0; j < 4; ++j) { a0[j] += __shfl_xor(a0[j], 16); a0[j] += __shfl_xor(a0[j], 32); a1[j] += __shfl_xor(a1[j], 16); a1[j] += __shfl_xor(a1[j], 32); }
        if (rs == 0) { *(LAS f32x4*)(part + (F.wave * 2 + 0) * 64 + cg * 4) = a0; *(LAS f32x4*)(part + (F.wave * 2 + 1) * 64 + cg * 4) = a1; }
        __syncthreads();
        if (F.tid < 128) { const int b = F.tid >> 6, col = F.tid & 63; float s = 0.f;
#pragma unroll
            for (int w = 0; w < 8; ++w) s += part[(w * 2 + b) * 64 + col];
            mod[(size_t)(l * 2 + b) * 6144 + cb * 64 + col] = s + A.in[I_ADAB][l * 6144 + cb * 64 + col]; }
        __syncthreads();
    }
    LAS float* scr = (LAS float*)(F.lds + F.wave * 12288);
    const int gw = F.vcu * NWAVES + F.wave, NGW = F.G * NWAVES;
    constexpr int I_QKV = 16 * 96, I_SQ = 16 * 32, I_GU = 2 * 16 * 2 * 256, I_DN = 2 * 16 * 256, I_FOLD = 64 * 32;
    constexpr int NITEMS = I_QKV + 2 * I_SQ + I_GU + I_DN + I_FOLD;
    for (int it = gw; it < NITEMS; it += NGW) {
        int r = it;
        if (r < I_FOLD) { fold_item(A.in[I_FWIN], (bf16_t*)(ws + WS_WFI), r, scr, tab, F.lane); continue; } r -= I_FOLD;
        if (r < I_QKV) { const int kb = r / 96, nb = r % 96; tr_item(A.in[I_AWIN], 3072, kb * 64, nb * 32, (bf16_t*)(ws + WS_WQKV), 1024, nb * 32, kb * 64, scr, F.lane); continue; } r -= I_QKV;
        if (r < I_SQ) { const int kb = r / 32, nb = r % 32; tr_item(A.in[I_AWOUT], 1024, kb * 64, nb * 32, (bf16_t*)(ws + WS_WO), 1024, nb * 32, kb * 64, scr, F.lane); continue; } r -= I_SQ;
        if (r < I_SQ) { const int kb = r / 32, nb = r % 32; tr_item(A.in[I_FWOUT], 1024, kb * 64, nb * 32, (bf16_t*)(ws + WS_WFO), 1024, nb * 32, kb * 64, scr, F.lane); continue; } r -= I_SQ;
        if (r < I_GU) { const int le = r >> 9, gu = (r >> 8) & 1, kb = (r >> 4) & 15, nb = r & 15, n0 = nb * 32;
            const float* src = (gu ? A.in[I_EWU] : A.in[I_EWG]) + (size_t)le * 1024 * 512;
            tr_item(src, 512, kb * 64, n0, (bf16_t*)(ws + WS_WGU) + (size_t)le * 1024 * 1024, 1024, (n0 >> 7) * 256 + gu * 128 + (n0 & 127), kb * 64, scr, F.lane); continue; } r -= I_GU;
        { const int le = r >> 8, kb = (r >> 5) & 7, nb = r & 31, lg = le >> 2, el = le & 3;
            const float* src = A.in[I_EWD] + (size_t)le * 512 * 1024;
            tr_item(src, 1024, kb * 64, nb * 32, (bf16_t*)(ws + WS_WD) + (size_t)lg * 1024 * 2048, 2048, nb * 32, el * 512 + kb * 64, scr, F.lane); }
    }
}

__device__ __forceinline__ void ld_row(const float* row, int lane, f32x4 (&v)[4]) {
    const GAS f32x4* xr = (const GAS f32x4*)row + lane;
#pragma unroll
    for (int j = 0; j < 4; ++j) v[j] = xr[64 * j];
}
__device__ __forceinline__ float row_rstd(const f32x4 (&v)[4]) {
    float s = 0.f;
#pragma unroll
    for (int j = 0; j < 4; ++j) s += (v[j].x * v[j].x + v[j].y * v[j].y) + (v[j].z * v[j].z + v[j].w * v[j].w);
    return 1.0f / sqrtf(wave_sum(s) * (1.0f / DM) + EPS);
}
__device__ __forceinline__ void norm_pass(Frame& F, const float* x, const float* g, const float* modl  , int sh_off, int sc_off, bf16_t* outb, float* outf) {
    const int gw = F.vcu * NWAVES + F.wave, NGW = F.G * NWAVES;
    f32x4 gv[4];
#pragma unroll
    for (int j = 0; j < 4; ++j) gv[j] = *((const GAS f32x4*)g + F.lane + 64 * j);
    for (int m = gw; m < TOK; m += NGW) {
        f32x4 v[4]; ld_row(x + (size_t)m * DM, F.lane, v);
        const float rstd = row_rstd(v);
        if (outb) {
            const float* mb = modl + (size_t)(m >> 13) * 6144;
            GAS u32x2* o8 = (GAS u32x2*)(outb + (size_t)m * DM) + F.lane;
#pragma unroll
            for (int j = 0; j < 4; ++j) { const f32x4 sh = *((const GAS f32x4*)(mb + sh_off) + F.lane + 64 * j), sc = *((const GAS f32x4*)(mb + sc_off) + F.lane + 64 * j);
                const f32x4 h = v[j] * rstd * gv[j] * (sc + 1.0f) + sh; u32x2 w; w.x = pk2(h.x, h.y); w.y = pk2(h.z, h.w); o8[64 * j] = w; }
        } else {
            GAS f32x4* o = (GAS f32x4*)(outf + (size_t)m * DM) + F.lane;
#pragma unroll
            for (int j = 0; j < 4; ++j) o[64 * j] = v[j] * rstd * gv[j];
        }
    }
}

struct DenseSched {
    int nM, nN, nwg, G, c; const char* A; const char* B; size_t tA, tB;
    __device__ void init(const void* A_, const void* B_, int M, int N, int lda, int ldb, int G_, int c_) { nM = M / 256; nN = N / 256; nwg = nM * nN; G = G_; c = c_; A = (const char*)A_; B = (const char*)B_; tA = (size_t)256 * lda * 2; tB = (size_t)256 * ldb * 2; }
    __device__ __forceinline__ bool next(int i, pg8::Unit& u) const {
        const long L = (long)i * G + c; if (L >= nwg) return false;
        int wgid = (int)L; { const int q = nwg / 8, r = nwg % 8, xcd = wgid % 8, off = wgid / 8; wgid = (xcd < r ? xcd * (q + 1) : r * (q + 1) + (xcd - r) * q) + off; }
        const int nig = 8 * nN, gid = wgid / nig, fm = gid * 8, gsz = (nM - fm) < 8 ? (nM - fm) : 8;
        u.pm = fm + ((wgid % nig) % gsz); u.pn = (wgid % nig) / gsz;
        u.a = A + (size_t)u.pm * tA; u.b = B + (size_t)u.pn * tB; u.jt = 1 << 30; u.jb = 0; u.aux0 = 0; u.aux1 = 0; return true;
    }
    __device__ __forceinline__ unsigned arow(const pg8::Unit&, int) const { return 0u; }
};
struct EpiBf16 {
    static constexpr bool PERM = true;
    bf16_t* O; int ldc; int split_cols; size_t split_stride; float scale0;
    __device__ __forceinline__ void operator()(const f32x4 (&acc)[2][2][4][2], const pg8::Unit& u, int wr, int wc, int fr, int fq) const {
        const int row0 = u.pm * 256 + wr * 64 + fr; int colt = u.pn * 256; bf16_t* base = O;
        float sc = 1.f; if (split_cols) { const int t = colt / split_cols; base += (size_t)t * split_stride; colt -= t * split_cols; if (t == 0) sc = scale0; }
        const int col0 = colt + wc * 32 + 8 * fq;
#pragma unroll
        for (int ai = 0; ai < 2; ++ai)
#pragma unroll
            for (int m = 0; m < 4; ++m) { bf16_t* rowp = base + (size_t)(row0 + ai * 128 + m * 16) * ldc + col0;
#pragma unroll
                for (int bj = 0; bj < 2; ++bj) { const f32x4 v0 = acc[ai][bj][m][0] * sc, v1 = acc[ai][bj][m][1] * sc;
                    u32x4 w; w.x = cvt_pk_bf16(v0[0], v0[1]); w.y = cvt_pk_bf16(v0[2], v0[3]); w.z = cvt_pk_bf16(v1[0], v1[1]); w.w = cvt_pk_bf16(v1[2], v1[3]);
                    *(u32x4*)(rowp + bj * 128) = w; } }
    }
};
struct EpiRes {
    static constexpr bool PERM = false;
    const float* xin; float* xout; const float* gate  ; int g_off;
    __device__ __forceinline__ void operator()(const f32x4 (&acc)[2][2][4][2], const pg8::Unit& u, int wr, int wc, int fr, int fq) const {
        const int row0 = u.pm * 256 + wr * 64 + fr, col0 = u.pn * 256 + wc * 32 + 4 * fq;
        const float* gb = gate + (size_t)((u.pm * 256) >> 13) * 6144 + g_off + col0;
        f32x4 gv[2][2];
#pragma unroll
        for (int bj = 0; bj < 2; ++bj)
#pragma unroll
            for (int n = 0; n < 2; ++n) gv[bj][n] = *(const f32x4*)(gb + bj * 128 + n * 16);
#pragma unroll
        for (int ai = 0; ai < 2; ++ai)
#pragma unroll
            for (int m = 0; m < 4; ++m) { const size_t off = (size_t)(row0 + ai * 128 + m * 16) * DM + col0;
#pragma unroll
                for (int bj = 0; bj < 2; ++bj)
#pragma unroll
                    for (int n = 0; n < 2; ++n) { const f32x4 xi = *(const f32x4*)(xin + off + bj * 128 + n * 16); *(f32x4*)(xout + off + bj * 128 + n * 16) = xi + gv[bj][n] * acc[ai][bj][m][n]; } }
    }
};

struct MoeTab { const LAS int* cnt; const LAS int* mts; };
__device__ __forceinline__ void pair_of(int pid, int& lo, int& hi) { lo = pid < 3 ? 0 : (pid < 5 ? 1 : 2); hi = pid < 3 ? pid + 1 : (pid < 5 ? pid - 1 : 3); }
__device__ __forceinline__ void moe_build_tab(Frame& F, const gu32* cntw, LAS int* tab) {
    __syncthreads();
    if (F.tid == 0) { int s = 0;
        for (int b = 0; b < NBUCKET; ++b) { const int c = (int)__hip_atomic_load(cntw + 64 * b, RLX_AGENT); tab[b] = c; tab[32 + b] = s; s += (c + 255) >> 8; }
        tab[32 + NBUCKET] = s; }
    __syncthreads();
}
struct Moe1Sched {
    const LAS int* tab; const int* list; const char* H; const char* W; int G, c;
    __device__ __forceinline__ bool next(int i, pg8::Unit& u) const {
        const int MT = tab[32 + NBUCKET], U = MT * 8; const long L = (long)i * G + c; if (L >= U) return false;
        const int wgid = (int)(L % 8) * MT + (int)(L / 8);
        const int mtg = wgid >> 3, nt = wgid & 7; int b = 0;
#pragma unroll 1
        for (int k = 1; k < NBUCKET; ++k) b = (tab[32 + k] <= mtg) ? k : b;
        const int g = b / 6; int lo, hi; pair_of(b % 6, lo, hi);
        const int e = g * 4 + ((nt >> 2) ? hi : lo), fb = nt & 3;
        u.pm = mtg; u.pn = nt; u.a = H; u.b = W + ((size_t)e * 1024 + fb * 256) * 1024 * 2; u.jt = 1 << 30; u.jb = 0; u.aux0 = b; u.aux1 = mtg - tab[32 + b]; return true;
    }
    __device__ __forceinline__ unsigned arow(const pg8::Unit& u, int r) const { const int idx = u.aux1 * 256 + r, c = tab[u.aux0]; return (unsigned)list[u.aux0 * 16384 + (idx < c ? idx : 0)]; }
};
struct Moe2Sched {
    const LAS int* tab; const char* HID; const char* W; int G, c;
    __device__ __forceinline__ bool next(int i, pg8::Unit& u) const {
        const int MT = tab[32 + NBUCKET], U = MT * 4; const long L = (long)i * G + c; if (L >= U) return false;
        int wgid = (int)L; { const int q = U / 8, r = U % 8, xcd = wgid % 8, off = wgid / 8; wgid = (xcd < r ? xcd * (q + 1) : r * (q + 1) + (xcd - r) * q) + off; }
        const int mtg = wgid >> 2, nt = wgid & 3; int b = 0;
#pragma unroll 1
        for (int k = 1; k < NBUCKET; ++k) b = (tab[32 + k] <= mtg) ? k : b;
        const int g = b / 6; int lo, hi; pair_of(b % 6, lo, hi);
        u.pm = mtg; u.pn = nt; u.a = HID + (size_t)mtg * 256 * 1024 * 2; u.b = W + (((size_t)g * 1024 + nt * 256) * 2048 + lo * 512) * 2; u.jt = 8; u.jb = (hi - lo - 1) * 512 * 2; u.aux0 = b; u.aux1 = mtg - tab[32 + b]; return true;
    }
    __device__ __forceinline__ unsigned arow(const pg8::Unit&, int) const { return 0u; }
};
struct EpiSwiGLU {
    static constexpr bool PERM = true;
    bf16_t* hid; const LAS int* tab; const int* list; const float* rw;
    __device__ __forceinline__ void operator()(const f32x4 (&acc)[2][2][4][2], const pg8::Unit& u, int wr, int wc, int fr, int fq) const {
        const int slot = u.pn >> 2, fb = u.pn & 3, cnt = tab[u.aux0];
#pragma unroll
        for (int ai = 0; ai < 2; ++ai)
#pragma unroll
            for (int m = 0; m < 4; ++m) { const int r = ai * 128 + wr * 64 + m * 16 + fr, idx = u.aux1 * 256 + r; const bool ok = idx < cnt;
                const int tok = list[u.aux0 * 16384 + (ok ? idx : 0)]; const float w = ok ? rw[tok * 2 + slot] : 0.f;
                float o[8];
#pragma unroll
                for (int n = 0; n < 2; ++n)
#pragma unroll
                    for (int j = 0; j < 4; ++j) { const float gt = acc[ai][0][m][n][j], up = acc[ai][1][m][n][j]; o[n * 4 + j] = gt * __builtin_amdgcn_rcpf(1.f + __builtin_amdgcn_exp2f(-gt * LOG2E)) * up * w; }
                u32x4 v; v.x = cvt_pk_bf16(o[0], o[1]); v.y = cvt_pk_bf16(o[2], o[3]); v.z = cvt_pk_bf16(o[4], o[5]); v.w = cvt_pk_bf16(o[6], o[7]);
                *(u32x4*)(hid + (size_t)(u.pm * 256 + r) * 1024 + slot * 512 + fb * 128 + wc * 32 + 8 * fq) = v; }
    }
};
struct EpiMoe2 {
    static constexpr bool PERM = false;
    float* x; const LAS int* tab; const int* list; const float* gate; int g_off;
    __device__ __forceinline__ void operator()(const f32x4 (&acc)[2][2][4][2], const pg8::Unit& u, int wr, int wc, int fr, int fq) const {
        const int cnt = tab[u.aux0], col0 = u.pn * 256 + wc * 32 + 4 * fq;
#pragma unroll
        for (int ai = 0; ai < 2; ++ai)
#pragma unroll
            for (int m = 0; m < 4; ++m) { const int r = ai * 128 + wr * 64 + m * 16 + fr, idx = u.aux1 * 256 + r;
                if (idx < cnt) { const int tok = list[u.aux0 * 16384 + idx]; const float* gb = gate + (size_t)(tok >> 13) * 6144 + g_off + col0; float* xr = x + (size_t)tok * DM + col0;
#pragma unroll
                    for (int bj = 0; bj < 2; ++bj)
#pragma unroll
                        for (int n = 0; n < 2; ++n) { const f32x4 gv = *(const f32x4*)(gb + bj * 128 + n * 16); f32x4* p = (f32x4*)(xr + bj * 128 + n * 16); *p = *p + gv * acc[ai][bj][m][n]; } } }
    }
};

namespace attn {
constexpr int QBLK = 32, KVBLK = 64, LD = 1024;
constexpr int SHM_V = KVBLK * DV * 2, SHM_K = KVBLK * DH * 2;
constexpr int LDS_TOTAL = 2 * SHM_V + 2 * SHM_K + NWAVES * 64 * 4;
constexpr float THR = 11.5f;
#define AT_KSWZ(row, colB) ((row) * 128 + ((colB) ^ ((((row) >> 1) & 7) << 4)))
#define AT_SBAR() __builtin_amdgcn_sched_barrier(0)
__device__ __forceinline__ int crow(int r, int hi) { return (r & 3) + 8 * (r >> 2) + 4 * hi; }
__device__ __forceinline__ void partialSM(f32x16& p0, f32x16& p1, float& m_reg, float& mn, float& alpha) {
    float pmax = p0[0];
#pragma unroll
    for (int r = 1; r < 16; ++r) pmax = fmaxf(pmax, p0[r]);
#pragma unroll
    for (int r = 0; r < 16; ++r) pmax = fmaxf(pmax, p1[r]);
    { auto rr = __builtin_amdgcn_permlane32_swap(__float_as_uint(pmax), __float_as_uint(pmax), false, false); pmax = fmaxf(__uint_as_float(rr[0]), __uint_as_float(rr[1])); }
    if (__builtin_expect(__all(pmax - m_reg <= THR), 1)) { mn = m_reg; alpha = 1.f; }
    else { mn = fmaxf(m_reg, pmax); alpha = __builtin_amdgcn_exp2f(m_reg - mn); m_reg = mn; }
#pragma unroll
    for (int r = 0; r < 16; ++r) p0[r] = p0[r] - mn;
#pragma unroll
    for (int r = 0; r < 16; ++r) p1[r] = p1[r] - mn;
#pragma unroll
    for (int r = 0; r < 16; ++r) p0[r] = __builtin_amdgcn_exp2f(p0[r]);
}
__device__ __forceinline__ void finishSM(f32x16& p0, f32x16& p1, float alpha, float& l_reg, bf16x8& pa0, bf16x8& pa1, bf16x8& pa2, bf16x8& pa3) {
#pragma unroll
    for (int r = 0; r < 16; ++r) p1[r] = __builtin_amdgcn_exp2f(p1[r]);
    float ps = 0;
#pragma unroll
    for (int r = 0; r < 16; ++r) ps += p0[r];
#pragma unroll
    for (int r = 0; r < 16; ++r) ps += p1[r];
    { auto rr = __builtin_amdgcn_permlane32_swap(__float_as_uint(ps), __float_as_uint(ps), false, false); ps = __uint_as_float(rr[0]) + __uint_as_float(rr[1]); }
    l_reg = l_reg * alpha + ps;
#define AT_PK4(P, BASE, OUT) do { unsigned a0 = cvt_pk_bf16(P[BASE + 0], P[BASE + 1]), a1 = cvt_pk_bf16(P[BASE + 2], P[BASE + 3]);   \
    unsigned b0 = cvt_pk_bf16(P[BASE + 4], P[BASE + 5]), b1 = cvt_pk_bf16(P[BASE + 6], P[BASE + 7]);                              \
    auto r0 = __builtin_amdgcn_permlane32_swap(a0, b0, false, false); auto r1 = __builtin_amdgcn_permlane32_swap(a1, b1, false, false); \
    u32x4 w = {r0[0], r1[0], r0[1], r1[1]}; OUT = __builtin_bit_cast(bf16x8, w); } while (0)
    AT_PK4(p0, 0, pa0); AT_PK4(p0, 8, pa1); AT_PK4(p1, 0, pa2); AT_PK4(p1, 8, pa3);
#undef AT_PK4
}
__device__ __forceinline__ void qkt(f32x16& p0, f32x16& p1, const LAS char* Ks, const bf16x8* qr, int r32, int hi, float dpos  , float nslope) {
    p0 = f32x16{}; p1 = f32x16{};
#pragma unroll
    for (int d0 = 0; d0 < 4; ++d0) { const int cb = (d0 * 16 + hi * 8) * 2;
        const bf16x8 b0 = *(const LAS bf16x8*)(Ks + AT_KSWZ(r32, cb));
        const bf16x8 b1 = *(const LAS bf16x8*)(Ks + AT_KSWZ(32 + r32, cb));
        p0 = __builtin_amdgcn_mfma_f32_32x32x16_bf16(b0, qr[d0], p0, 0, 0, 0);
        p1 = __builtin_amdgcn_mfma_f32_32x32x16_bf16(b1, qr[d0], p1, 0, 0, 0); }
#pragma unroll
    for (int r = 0; r < 16; ++r) { const float c = (float)((r & 3) + 8 * (r >> 2)); p0[r] = fmaf(nslope, fabsf(dpos - c), p0[r]); p1[r] = fmaf(nslope, fabsf(dpos - (c + 32.f)), p1[r]); }
}
__device__ __forceinline__ int v_st(int k, int c) { const int kk = (k & ~0xC) | ((k & 4) << 1) | ((k & 8) >> 1); return ((kk >> 3) * 4 + (c >> 5)) * 512 + ((kk & 7) * 32 + (c & 31)) * 2; }
__device__ __forceinline__ int v_rd_base(int lane) { return ((lane & 3) << 3) | (((lane >> 2) & 3) << 6) | (((lane >> 4) & 1) << 5) | (((lane >> 5) & 1) << 8); }
constexpr int v_rd_off(int d0, int ks, int half) { return d0 * 512 + ks * 4096 + half * 2048; }
template <int OFF> __device__ __forceinline__ s16x4 tr_read(int vb) { s16x4 r; asm volatile("ds_read_b64_tr_b16 %0, %1 offset:%2" : "=&v"(r) : "v"(vb), "i"(OFF) : "memory"); return r; }
template <int D0> __device__ __forceinline__ void pv_one(f32x16& od, int vb, bf16x8 pa0, bf16x8 pa1, bf16x8 pa2, bf16x8 pa3) {
    const s16x4 l0 = tr_read<v_rd_off(D0, 0, 0)>(vb), h0 = tr_read<v_rd_off(D0, 0, 1)>(vb), l1 = tr_read<v_rd_off(D0, 1, 0)>(vb), h1 = tr_read<v_rd_off(D0, 1, 1)>(vb);
    const s16x4 l2 = tr_read<v_rd_off(D0, 2, 0)>(vb), h2 = tr_read<v_rd_off(D0, 2, 1)>(vb), l3 = tr_read<v_rd_off(D0, 3, 0)>(vb), h3 = tr_read<v_rd_off(D0, 3, 1)>(vb);
    asm volatile("s_waitcnt lgkmcnt(0)" ::: "memory"); AT_SBAR();
#define AT_PK(L, H) (bf16x8){L[0], L[1], L[2], L[3], H[0], H[1], H[2], H[3]}
    od = __builtin_amdgcn_mfma_f32_32x32x16_bf16(pa0, AT_PK(l0, h0), od, 0, 0, 0);
    od = __builtin_amdgcn_mfma_f32_32x32x16_bf16(pa1, AT_PK(l1, h1), od, 0, 0, 0);
    od = __builtin_amdgcn_mfma_f32_32x32x16_bf16(pa2, AT_PK(l2, h2), od, 0, 0, 0);
    od = __builtin_amdgcn_mfma_f32_32x32x16_bf16(pa3, AT_PK(l3, h3), od, 0, 0, 0);
#undef AT_PK
}
__device__ __forceinline__ void pv_d0(f32x16* o, int vb, bf16x8 pa0, bf16x8 pa1, bf16x8 pa2, bf16x8 pa3) {
    pv_one<0>(o[0], vb, pa0, pa1, pa2, pa3); pv_one<1>(o[1], vb, pa0, pa1, pa2, pa3); pv_one<2>(o[2], vb, pa0, pa1, pa2, pa3); pv_one<3>(o[3], vb, pa0, pa1, pa2, pa3);
}
__device__ __forceinline__ void unit(const bf16_t* __restrict__ Qh, const bf16_t* __restrict__ Kh, const bf16_t* __restrict__ Vh, bf16_t* __restrict__ Oh, int q0, float nslope, LAS char* lds) {
    int tid = threadIdx.x; asm volatile("" : "+v"(tid));
    const int wid = __builtin_amdgcn_readfirstlane(tid >> 6), lane = tid & 63, r32 = lane & 31, hi = lane >> 5;
    LAS char* V_lds = lds; LAS char* K_lds = lds + 2 * SHM_V;
    LAS float* ws = (LAS float*)(lds + 2 * SHM_V + 2 * SHM_K) + wid * 64; LAS float* li_l = ws; LAS float* al_l = ws + 32;
    float m_reg = -1e30f, l_reg = 0; f32x16 o[4] = {}; bf16x8 qr[4];
    const bf16_t* Qw = Qh + (size_t)(q0 + wid * QBLK + r32) * LD + hi * 8;
#pragma unroll
    for (int d0 = 0; d0 < 4; ++d0) qr[d0] = *(const bf16x8*)(Qw + d0 * 16);
    const float qpos = (float)(q0 + wid * QBLK + r32) - 4.f * (float)hi;
    const int sr = tid >> 4, sc = (tid & 15) * 8, vst0 = v_st(sr, sc), vst1 = v_st(32 + sr, sc);
    const int kr = tid >> 3, kc = (tid & 7) * 8, kst = AT_KSWZ(kr, kc * 2);
    const int vb0 = (int)(uintptr_t)V_lds + v_rd_base(lane);
    struct { bf16x8 vs0, vs1, ks0; } sr_[2];
#define AT_SLOAD(i, k0) do { sr_[i].vs0 = *(const bf16x8*)(&Vh[(size_t)((k0) + sr) * LD + sc]); sr_[i].vs1 = *(const bf16x8*)(&Vh[(size_t)((k0) + 32 + sr) * LD + sc]); \
    sr_[i].ks0 = *(const bf16x8*)(&Kh[(size_t)((k0) + kr) * LD + kc]); } while (0)
#define AT_SWRITE(b, i) do { *(LAS bf16x8*)(V_lds + (b) * SHM_V + vst0) = sr_[i].vs0; *(LAS bf16x8*)(V_lds + (b) * SHM_V + vst1) = sr_[i].vs1; \
    *(LAS bf16x8*)(K_lds + (b) * SHM_K + kst) = sr_[i].ks0; } while (0)
#define AT_SWAIT() asm volatile("s_waitcnt vmcnt(3)" ::: "memory")
#define AT_RESC(a) do { if (__any((a) < 1.f)) { if (hi == 0) al_l[r32] = (a); asm volatile("s_waitcnt lgkmcnt(0)" ::: "memory"); \
    _Pragma("unroll") for (int d = 0; d < 4; ++d) _Pragma("unroll") for (int r = 0; r < 16; ++r) o[d][r] *= al_l[crow(r, hi)]; } } while (0)
    f32x16 pA0, pA1, pB0, pB1; float mnA, mnB, alA, alB; bf16x8 pa0, pa1, pa2, pa3; constexpr int NT = SEQ / KVBLK;
    AT_SLOAD(0, 0); asm volatile("s_waitcnt vmcnt(0)" ::: "memory"); AT_SWRITE(0, 0); __syncthreads();
    qkt(pA0, pA1, K_lds, qr, r32, hi, qpos, nslope); partialSM(pA0, pA1, m_reg, mnA, alA);
    AT_SLOAD(1, KVBLK); AT_SLOAD(0, 2 * KVBLK);
    AT_SWAIT(); AT_SWRITE(1, 1); __syncthreads();
    for (int j = 1; j + 1 < NT; j += 2) {
        AT_SBAR(); qkt(pB0, pB1, K_lds + SHM_K, qr, r32, hi, qpos - (float)(j * KVBLK), nslope);
        finishSM(pA0, pA1, alA, l_reg, pa0, pa1, pa2, pa3); AT_SBAR();
        AT_SLOAD(1, (j + 2) * KVBLK); AT_SBAR();
        pv_d0(o, vb0, pa0, pa1, pa2, pa3); partialSM(pB0, pB1, m_reg, mnB, alB);
        __syncthreads(); AT_SWAIT(); AT_SWRITE(0, 0);
        AT_RESC(alB); __syncthreads();
        AT_SBAR(); qkt(pA0, pA1, K_lds, qr, r32, hi, qpos - (float)((j + 1) * KVBLK), nslope);
        finishSM(pB0, pB1, alB, l_reg, pa0, pa1, pa2, pa3); AT_SBAR();
        if (j + 3 < NT) AT_SLOAD(0, (j + 3) * KVBLK); AT_SBAR();
        pv_d0(o, vb0 + SHM_V, pa0, pa1, pa2, pa3); partialSM(pA0, pA1, m_reg, mnA, alA);
        __syncthreads(); AT_SWAIT(); AT_SWRITE(1, 1);
        AT_RESC(alA); __syncthreads();
    }
    AT_SBAR(); qkt(pB0, pB1, K_lds + SHM_K, qr, r32, hi, qpos - (float)((NT - 1) * KVBLK), nslope);
    finishSM(pA0, pA1, alA, l_reg, pa0, pa1, pa2, pa3); AT_SBAR();
    pv_d0(o, vb0, pa0, pa1, pa2, pa3); partialSM(pB0, pB1, m_reg, mnB, alB);
    __syncthreads(); AT_RESC(alB);
    finishSM(pB0, pB1, alB, l_reg, pa0, pa1, pa2, pa3); AT_SBAR();
    pv_d0(o, vb0 + SHM_V, pa0, pa1, pa2, pa3);
    if (hi == 0) li_l[r32] = l_reg; asm volatile("s_waitcnt lgkmcnt(0)" ::: "memory");
    float rli[16];
#pragma unroll
    for (int r = 0; r < 16; ++r) rli[r] = __builtin_amdgcn_rcpf(li_l[crow(r, hi)]);
    bf16_t* Ow = Oh + (size_t)(q0 + wid * QBLK) * LD;
#pragma unroll
    for (int r = 0; r < 16; ++r) { const int orow = crow(r, hi);
#pragma unroll
        for (int d0 = 0; d0 < 4; ++d0) Ow[(size_t)orow * LD + d0 * 32 + r32] = (bf16_t)f2bf(o[d0][r] * rli[r]); }
    __syncthreads();
#undef AT_SLOAD
#undef AT_SWRITE
#undef AT_SWAIT
#undef AT_RESC
}
}

__device__ __forceinline__ void combine_pass(Frame& F, const Args& A, const bf16_t* o1, const bf16_t* o2, bf16_t* out) {
    const int gw = F.vcu * NWAVES + F.wave, NGW = F.G * NWAVES;
    const float d1 = wave_sum(A.in[I_LQ1][F.lane] * A.in[I_LK1][F.lane]), d2 = wave_sum(A.in[I_LQ2][F.lane] * A.in[I_LK2][F.lane]);
    const float lam_init = 0.8f - 0.6f * 1.0f;
    const float lam = __expf(d1) - __expf(d2) + lam_init;
    float gsub[16];
#pragma unroll
    for (int j = 0; j < 16; ++j) gsub[j] = A.in[I_SUBLN][(F.lane & 7) * 16 + j] * (1.0f - lam_init);
    for (int m = gw; m < TOK; m += NGW) {
        const u32x4* p1 = (const u32x4*)(o1 + (size_t)m * DM + F.lane * 16); const u32x4* p2 = (const u32x4*)(o2 + (size_t)m * DM + F.lane * 16);
        const u32x4 a0 = p1[0], a1 = p1[1], b0 = p2[0], b1 = p2[1];
        float v[16]; float s = 0.f;
#pragma unroll
        for (int j = 0; j < 4; ++j) {
            const unsigned ua = a0[j], ub = b0[j], uc = a1[j], ud = b1[j];
            v[2 * j]     = __builtin_bit_cast(float, ua << 16) - lam * __builtin_bit_cast(float, ub << 16);
            v[2 * j + 1] = __builtin_bit_cast(float, ua & 0xffff0000u) - lam * __builtin_bit_cast(float, ub & 0xffff0000u);
            v[8 + 2 * j]     = __builtin_bit_cast(float, uc << 16) - lam * __builtin_bit_cast(float, ud << 16);
            v[8 + 2 * j + 1] = __builtin_bit_cast(float, uc & 0xffff0000u) - lam * __builtin_bit_cast(float, ud & 0xffff0000u);
        }
#pragma unroll
        for (int j = 0; j < 16; ++j) s += v[j] * v[j];
        s += __shfl_xor(s, 1); s += __shfl_xor(s, 2); s += __shfl_xor(s, 4);
        const float rstd = 1.0f / sqrtf(s * (1.0f / 128.0f) + EPS);
        u32x4 w0, w1;
        w0.x = pk2(v[0] * rstd * gsub[0], v[1] * rstd * gsub[1]); w0.y = pk2(v[2] * rstd * gsub[2], v[3] * rstd * gsub[3]); w0.z = pk2(v[4] * rstd * gsub[4], v[5] * rstd * gsub[5]); w0.w = pk2(v[6] * rstd * gsub[6], v[7] * rstd * gsub[7]);
        w1.x = pk2(v[8] * rstd * gsub[8], v[9] * rstd * gsub[9]); w1.y = pk2(v[10] * rstd * gsub[10], v[11] * rstd * gsub[11]); w1.z = pk2(v[12] * rstd * gsub[12], v[13] * rstd * gsub[13]); w1.w = pk2(v[14] * rstd * gsub[14], v[15] * rstd * gsub[15]);
        u32x4* po = (u32x4*)(out + (size_t)m * DM + F.lane * 16); po[0] = w0; po[1] = w1;
    }
}

__device__ __forceinline__ void router_pass(Frame& F, const Args& A, int layer, const float* x, bf16_t* outb, gu32* cntw, int* list, float* rw) {
    const int gw = F.vcu * NWAVES + F.wave, NGW = F.G * NWAVES;
    const float* g = A.in[I_NFFN] + layer * DM; const float* modl = (const float*)(F.ws + WS_MISC + MS_MOD) + (size_t)layer * 2 * 6144;
    const float* rgw = A.in[I_RGW] + (size_t)layer * DM * 4; const float* rgb = A.in[I_RGB] + layer * 4;
    const float* rew = A.in[I_REW] + (size_t)layer * DM * 16; const float* reb = A.in[I_REB] + layer * 16;
    f32x4 gv[4];
#pragma unroll
    for (int j = 0; j < 4; ++j) gv[j] = *((const GAS f32x4*)g + F.lane + 64 * j);
    for (int m = gw; m < TOK; m += NGW) {
        f32x4 v[4]; ld_row(x + (size_t)m * DM, F.lane, v);
        const float rstd = row_rstd(v);
        const float* mb = modl + (size_t)(m >> 13) * 6144;
        GAS u32x2* o8 = (GAS u32x2*)(outb + (size_t)m * DM) + F.lane;
        float lg[4] = {0.f, 0.f, 0.f, 0.f};
#pragma unroll
        for (int j = 0; j < 4; ++j) { const f32x4 sh = *((const GAS f32x4*)(mb + 3072) + F.lane + 64 * j), sc = *((const GAS f32x4*)(mb + 4096) + F.lane + 64 * j);
            v[j] = v[j] * rstd * gv[j] * (sc + 1.0f) + sh; u32x2 w; w.x = pk2(v[j].x, v[j].y); w.y = pk2(v[j].z, v[j].w); o8[64 * j] = w;
            const GAS f32x4* wr = (const GAS f32x4*)rgw + (4 * F.lane + 256 * j);
#pragma unroll
            for (int e = 0; e < 4; ++e) { const f32x4 w4 = wr[e]; lg[0] += v[j][e] * w4.x; lg[1] += v[j][e] * w4.y; lg[2] += v[j][e] * w4.z; lg[3] += v[j][e] * w4.w; } }
#pragma unroll
        for (int e = 0; e < 4; ++e) lg[e] = wave_sum(lg[e]) + rgb[e];
        int gi = 0; float gm = lg[0];
#pragma unroll
        for (int e = 1; e < 4; ++e) if (lg[e] > gm) { gm = lg[e]; gi = e; }
        float gden = 0.f;
#pragma unroll
        for (int e = 0; e < 4; ++e) gden += __expf(lg[e] - gm);
        const float gprob = 1.0f / gden;
        gi = __builtin_amdgcn_readfirstlane(gi);
        float le[4] = {0.f, 0.f, 0.f, 0.f};
#pragma unroll
        for (int j = 0; j < 4; ++j) { const GAS f32x4* wr = (const GAS f32x4*)rew + (size_t)(4 * F.lane + 256 * j) * 4 + gi;
#pragma unroll
            for (int e = 0; e < 4; ++e) { const f32x4 w4 = wr[e * 4]; le[0] += v[j][e] * w4.x; le[1] += v[j][e] * w4.y; le[2] += v[j][e] * w4.z; le[3] += v[j][e] * w4.w; } }
#pragma unroll
        for (int e = 0; e < 4; ++e) le[e] = wave_sum(le[e]) + reb[gi * 4 + e];
        int i1 = 0; float v1 = le[0];
#pragma unroll
        for (int e = 1; e < 4; ++e) if (le[e] > v1) { v1 = le[e]; i1 = e; }
        int i2 = -1; float v2 = -3.0e38f;
#pragma unroll
        for (int e = 0; e < 4; ++e) if (e != i1 && le[e] > v2) { v2 = le[e]; i2 = e; }
        const float w1 = 1.0f / (1.0f + __expf(v2 - v1)), w2 = 1.0f - w1;
        const int lo = i1 < i2 ? i1 : i2, hi = i1 < i2 ? i2 : i1;
        const float wlo = (i1 < i2 ? w1 : w2) * gprob, whi = (i1 < i2 ? w2 : w1) * gprob;
        const int pid = lo == 0 ? hi - 1 : (lo == 1 ? hi + 1 : 5);
        const int bkt = gi * 6 + pid;
        if (F.lane == 0) { const unsigned pos = __hip_atomic_fetch_add(cntw + 64 * bkt, 1u, RLX_AGENT); list[bkt * 16384 + pos] = m; rw[m * 2] = wlo; rw[m * 2 + 1] = whi; }
    }
}

__device__ __forceinline__ void fft_phase(Frame& F, const bf16_t* zT, bf16_t* fT) {
    LAS float* re = (LAS float*)F.lds; LAS float* im = re + 8192; LAS float* twc = im + 8192; LAS float* tws = twc + 4096;
    const float* tw = (const float*)(F.ws + WS_MISC + MS_TW);
    for (int i = F.tid; i < 4096; i += NTHREADS) { twc[i] = tw[i]; tws[i] = tw[8192 + i]; }
    __syncthreads();
    for (int job = F.vcu; job < 2048; job += F.G) {
        const int l = job >> 1, b = job & 1;
        const bf16_t* uc = zT + (size_t)l * TOK + b * SEQ; const bf16_t* us = zT + (size_t)(1024 + l) * TOK + b * SEQ;
#pragma unroll
        for (int it = 0; it < 2; ++it) { const int s0 = 8 * (F.tid + NTHREADS * it); const u32x4 a = *(const u32x4*)(uc + s0), c = *(const u32x4*)(us + s0);
#pragma unroll
            for (int e = 0; e < 8; ++e) { const unsigned ua = a[e >> 1], uc2 = c[e >> 1]; const float fr = (e & 1) ? __builtin_bit_cast(float, ua & 0xffff0000u) : __builtin_bit_cast(float, ua << 16);
                const float fi = (e & 1) ? __builtin_bit_cast(float, uc2 & 0xffff0000u) : __builtin_bit_cast(float, uc2 << 16);
                const int d = (int)(__builtin_bitreverse32((unsigned)(s0 + e)) >> 19); re[d] = fr; im[d] = -fi; } }
        __syncthreads();
#pragma unroll 1
        for (int lg = 0; lg < 13; ++lg) { const int mm = 1 << lg;
#pragma unroll
            for (int it = 0; it < 8; ++it) { const int j = F.tid + NTHREADS * it, pos = j & (mm - 1), i0 = ((j >> lg) << (lg + 1)) + pos, i1 = i0 + mm, ti = pos << (12 - lg);
                const float c = twc[ti], s = tws[ti]; const float xr = re[i1], xi = im[i1], yr = re[i0], yi = im[i0];
                const float tr = c * xr + s * xi, tim = c * xi - s * xr;
                re[i0] = yr + tr; im[i0] = yi + tim; re[i1] = yr - tr; im[i1] = yi - tim; }
            __syncthreads(); }
        bf16_t* o = fT + (size_t)l * TOK + b * SEQ;
#pragma unroll
        for (int it = 0; it < 2; ++it) { const int k0 = 8 * (F.tid + NTHREADS * it); const f32x4 r0 = *(const LAS f32x4*)(re + k0), r1 = *(const LAS f32x4*)(re + k0 + 4); const float sc = 0.011048543456039806f;
            u32x4 w; w.x = pk2(r0.x * sc, r0.y * sc); w.y = pk2(r0.z * sc, r0.w * sc); w.z = pk2(r1.x * sc, r1.y * sc); w.w = pk2(r1.z * sc, r1.w * sc); *(u32x4*)(o + k0) = w; }
        __syncthreads();
    }
}
__device__ __forceinline__ void transpose_phase(Frame& F, const bf16_t* fT, bf16_t* f) {
    LAS unsigned short* tile = (LAS unsigned short*)(F.lds + F.wave * 12288);
    const int gw = F.vcu * NWAVES + F.wave, NGW = F.G * NWAVES;
    for (int t = gw; t < 16 * 256; t += NGW) { const int lb = t >> 8, tb = t & 255;
#pragma unroll
        for (int it = 0; it < 8; ++it) { const int r = it * 8 + (F.lane >> 3), ch = F.lane & 7; *(LAS u32x4*)(tile + r * 72 + ch * 8) = *(const u32x4*)(fT + (size_t)(lb * 64 + r) * TOK + tb * 64 + ch * 8); }
        LDS_WAIT(); asm volatile("" ::: "memory");
#pragma unroll
        for (int it = 0; it < 8; ++it) { const int tk = it * 8 + (F.lane >> 3), c = F.lane & 7; unsigned short e[8];
#pragma unroll
            for (int q = 0; q < 8; ++q) e[q] = tile[(8 * c + q) * 72 + tk];
            u32x4 w; w.x = e[0] | ((unsigned)e[1] << 16); w.y = e[2] | ((unsigned)e[3] << 16); w.z = e[4] | ((unsigned)e[5] << 16); w.w = e[6] | ((unsigned)e[7] << 16);
            *(u32x4*)(f + (size_t)(tb * 64 + tk) * DM + lb * 64 + c * 8) = w; }
        LDS_WAIT(); asm volatile("" ::: "memory");
    }
}

#ifndef MK_N_LAUNCHES
#define MK_N_LAUNCHES 1
#endif
constexpr int N_PHASES = 18;
__global__ void __launch_bounds__(NTHREADS, 2) mk_fwd(Args args) {
    extern __shared__ __attribute__((aligned(16))) unsigned char lds_raw[];
    Frame F;
    F.lds = (LAS unsigned char*)lds_raw;
    F.tid = threadIdx.x; F.lane = F.tid & 63; F.wave = __builtin_amdgcn_readfirstlane(F.tid >> 6);
    F.G = gridDim.x; { const int bx = blockIdx.x; F.vcu = (F.G % 8 == 0) ? (bx % 8) * (F.G / 8) + bx / 8 : bx; }
    F.ws = args.ws; F.ctl = (gu32*)(args.ws + WS_CTL);
    unsigned char* ws = args.ws;
    for (int u = F.tid; u < (LDS_BYTES - LDSCTL_OFF) / 4; u += NTHREADS) ((LAS unsigned*)(F.lds + LDSCTL_OFF))[u] = 0u;
    __syncthreads();
    volatile LAS unsigned* MISC = (volatile LAS unsigned*)(F.lds + MISC_OFF);
    LAS int* mtab = (LAS int*)(F.lds + RING_BYTES + 1024);
    XcdBarrier bar = xcd_barrier_post((unsigned*)(F.ctl + CW_BAR), MISC + 8);
    const int lo = args.ph_lo, hi = args.ph_hi;
#ifndef PH_MASK
#define PH_MASK 0x3ffff
#endif
#define IN(k) (((PH_MASK >> (k)) & 1) && lo <= (k) && (k) < hi)
#define SEAM(k) do { if (IN((k) + 1)) xcd_barrier(bar); } while (0)
    float* mod = (float*)(ws + WS_MISC + MS_MOD);
    float* X = (float*)(ws + WS_X); bf16_t* H = (bf16_t*)(ws + WS_H);
    bf16_t* Qb = (bf16_t*)(ws + WS_Q); bf16_t* Kb = (bf16_t*)(ws + WS_K); bf16_t* Vb = (bf16_t*)(ws + WS_V);
    bf16_t* ON = (bf16_t*)args.out;
    int* list = (int*)(ws + WS_LIST); float* rw = (float*)(ws + WS_MISC + MS_RW);
    bf16_t* HID = (bf16_t*)(ws + WS_HID); bf16_t* ZT = (bf16_t*)(ws + WS_ZT); bf16_t* FT = (bf16_t*)(ws + WS_FT);

#define REFRESH() do { int t_ = threadIdx.x; asm volatile("" : "+v"(t_)); F.tid = t_; F.lane = t_ & 63; } while (0)
    if (IN(0)) { p0_prologue(F, args); SEAM(0); }
    if (IN(1)) { REFRESH(); norm_pass(F, args.in[I_X], args.in[I_NMIX], mod, 0, 1024, H, nullptr); SEAM(1); }
    if (IN(2)) { DenseSched S; S.init(H, ws + WS_WQKV, TOK, 3072, 1024, 1024, F.G, (int)blockIdx.x);
        EpiBf16 E{Qb, 1024, 1024, (size_t)TOK * DM, 0.125f * LOG2E};
        pg8::gemm_phase<EpiBf16, DenseSched, false>(F.lds, 1024, 1024, 1024, S, E); SEAM(2); }
    if (IN(3)) {
        for (int i = 0; i < 4; ++i) { const int id = F.vcu * 4 + i; if (id < 1024) { const int bh = id >> 5, qb = id & 31, b = bh >> 4, h16 = bh & 15, head = h16 >> 1, which = h16 & 1;
            const size_t rb = (size_t)b * SEQ * DM; const float nslope = -exp2f(-(float)(head + 1)) * LOG2E;
            attn::unit(Qb + rb + h16 * 64, Kb + rb + h16 * 64, Vb + rb + head * 128, ON + (size_t)which * TOK * DM + rb + head * 128, qb * 256, nslope, (LAS char*)F.lds); } }
        SEAM(3); }
    if (IN(4)) { REFRESH(); combine_pass(F, args, ON, ON + (size_t)TOK * DM, H); SEAM(4); }
    if (IN(5)) { DenseSched S; S.init(H, ws + WS_WO, TOK, 1024, 1024, 1024, F.G, (int)blockIdx.x);
        EpiRes E{args.in[I_X], X, mod, 2048};
        pg8::gemm_phase<EpiRes, DenseSched, false>(F.lds, 1024, 1024, 1024, S, E); SEAM(5); }
#define MOE_LAYER(layer, pb) do { \
        gu32* cntw = F.ctl + CW_CNT + (layer) * NBUCKET * 64; \
        const float* modl = mod + (size_t)(layer) * 2 * 6144; \
        if (IN(pb)) { REFRESH(); router_pass(F, args, (layer), X, H, cntw, list, rw); SEAM(pb); } \
        if (IN((pb) + 1)) { REFRESH(); moe_build_tab(F, cntw, mtab); \
            Moe1Sched S{mtab, list, (const char*)H, (const char*)(ws + WS_WGU) + (size_t)(layer) * 16 * 1024 * 1024 * 2, F.G, F.vcu}; \
            EpiSwiGLU E{HID, mtab, list, rw}; \
            pg8::gemm_phase<EpiSwiGLU, Moe1Sched, true>(F.lds, 1024, 1024, 1024, S, E); SEAM((pb) + 1); } \
        if (IN((pb) + 2)) { REFRESH(); moe_build_tab(F, cntw, mtab); \
            Moe2Sched S{mtab, (const char*)HID, (const char*)(ws + WS_WD) + (size_t)(layer) * 4 * 1024 * 2048 * 2, F.G, F.vcu}; \
            EpiMoe2 E{X, mtab, list, modl, 5120}; \
            pg8::gemm_phase<EpiMoe2, Moe2Sched, false>(F.lds, 1024, 1024, 2048, S, E); SEAM((pb) + 2); } } while (0)
    MOE_LAYER(0, 6);
    if (IN(9)) { REFRESH(); norm_pass(F, X, args.in[I_NMIX] + DM, mod + 2 * 6144, 0, 1024, H, nullptr); SEAM(9); }
    if (IN(10)) { DenseSched S; S.init(ws + WS_WFI, H, 2048, TOK, 1024, 1024, F.G, (int)blockIdx.x);
        EpiBf16 E{ZT, TOK, 0, 0, 1.f};
        pg8::gemm_phase<EpiBf16, DenseSched, false>(F.lds, 1024, 1024, 1024, S, E); SEAM(10); }
    if (IN(11)) { REFRESH(); fft_phase(F, ZT, FT); SEAM(11); }
    if (IN(12)) { REFRESH(); transpose_phase(F, FT, H); SEAM(12); }
    if (IN(13)) { DenseSched S; S.init(H, ws + WS_WFO, TOK, 1024, 1024, 1024, F.G, (int)blockIdx.x);
        EpiRes E{X, X, mod + 2 * 6144, 2048};
        pg8::gemm_phase<EpiRes, DenseSched, false>(F.lds, 1024, 1024, 1024, S, E); SEAM(13); }
    MOE_LAYER(1, 14);
    if (IN(17)) { REFRESH(); norm_pass(F, X, args.in[I_NFIN], nullptr, 0, 0, nullptr, args.out); }
#undef IN
#undef SEAM
}

extern "C" void kernel_launch(void* const* d_in, const int* in_sizes, int n_in, void* d_out, int out_size, void* d_ws, size_t ws_size, hipStream_t stream) {
    static int ok = 0;
    if (ok == 0) {
        if (n_in != 23 || in_sizes[0] != TOK * DM || out_size != TOK * DM || ws_size < WS_END) { fprintf(stderr, "kernel_launch: unexpected shapes (n_in %d, in0 %d, out %d, ws %zu < %zu); nothing launched\n", n_in, n_in > 0 ? in_sizes[0] : -1, out_size, ws_size, (size_t)WS_END); ok = -1; return; }
        if (hipFuncSetAttribute((const void*)mk_fwd, hipFuncAttributeMaxDynamicSharedMemorySize, LDS_BYTES) != hipSuccess) { fprintf(stderr, "kernel_launch: hipFuncSetAttribute failed\n"); ok = -1; return; }
        ok = 1;
    }
    if (ok < 0) return;
    (void)hipMemsetAsync((char*)d_ws + WS_CTL, 0, CTL_ZERO_BYTES, stream);
    Args a{};
    for (int i = 0; i < 23; ++i) a.in[i] = (const float*)d_in[i];
    a.out = (float*)d_out; a.ws = (unsigned char*)d_ws;
#if MK_N_LAUNCHES == 1
    a.ph_lo = 0; a.ph_hi = N_PHASES;
    hipLaunchKernelGGL(mk_fwd, dim3(256), dim3(NTHREADS), LDS_BYTES, stream, a);
#else
    for (int p = 0; p < N_PHASES; ++p) { a.ph_lo = p; a.ph_hi = p + 1; hipLaunchKernelGGL(mk_fwd, dim3(256), dim3(NTHREADS), LDS_BYTES, stream, a); }
#endif
}
```

```cpp
#include <hip/hip_runtime.h>
#include <cstdio>
#include <cstdint>

#define LAS __attribute__((address_space(3)))
#define GAS __attribute__((address_space(1)))
typedef unsigned short bf16_t;
typedef short bf16x8 __attribute__((ext_vector_type(8)));
typedef short s16x4 __attribute__((ext_vector_type(4)));
typedef float f32x4 __attribute__((ext_vector_type(4)));
typedef float f32x2 __attribute__((ext_vector_type(2)));
typedef float f32x16 __attribute__((ext_vector_type(16)));
typedef unsigned u32x4 __attribute__((ext_vector_type(4)));
typedef unsigned u32x2 __attribute__((ext_vector_type(2)));
typedef GAS unsigned gu32;

constexpr int NB = 2, SEQ = 8192, DM = 1024, TOK = NB * SEQ;
constexpr int NHEAD = 8, DH = 64, DV = 128;
constexpr int NEXP = 16, DEXP = 512, NBUCKET = 24;
constexpr int NWAVES = 8, NTHREADS = 512;
constexpr float EPS = 1e-6f;
constexpr float LOG2E = 1.4426950408889634f;

__device__ __forceinline__ unsigned f2bf(float f) { unsigned u = __builtin_bit_cast(unsigned, f); return (u + 0x7fffu + ((u >> 16) & 1u)) >> 16; }
__device__ __forceinline__ unsigned pk2(float lo, float hi) { return f2bf(lo) | (f2bf(hi) << 16); }
__device__ __forceinline__ float bf2f(unsigned short h) { return __builtin_bit_cast(float, (unsigned)h << 16); }
__device__ __forceinline__ unsigned cvt_pk_bf16(float lo, float hi) { unsigned r; asm volatile("v_cvt_pk_bf16_f32 %0, %1, %2" : "=v"(r) : "v"(lo), "v"(hi)); return r; }
__device__ __forceinline__ float wave_sum(float v) {
#pragma unroll
    for (int o = 1; o < 64; o <<= 1) v += __shfl_xor(v, o);
    return v;
}

namespace pg8 {
constexpr int BM = 256, BK = 64, HALF = 128, HTB = HALF * BK * 2, STAGE_BYTES = 8 * HTB, NXCD = 8;
__host__ __device__ __forceinline__ int lds_byte(int r, int c) { const int st = (r >> 4) * 2 + (c >> 5), rr = r & 15, cc = c & 31, ob = rr * 64 + cc * 2; return st * 1024 + (ob ^ (((ob >> 9) & 1) << 5)); }
__host__ __device__ __forceinline__ void stage_rc(int b, int& R, int& C) { const int st = b / 1024, sb = b % 1024, swz = sb ^ (((sb >> 9) & 1) << 5); R = (st >> 1) * 16 + swz / 64; C = (st & 1) * 32 + (swz % 64) / 2; }
__host__ __device__ __forceinline__ int perm32(int rho) { const int n = rho >> 4, i = rho & 15; return 8 * (i >> 2) + 4 * n + (i & 3); }

struct Unit { int pm, pn; const char* a; const char* b; int jt; int jb; int aux0, aux1; };

template <class Epi, class Sched, bool GATHER>
__device__ __forceinline__ void gemm_phase(LAS unsigned char* lds, const int K, const int lda, const int ldb, const Sched& S, const Epi& E) {
    int tid = threadIdx.x; asm volatile("" : "+v"(tid));
    const int wid = __builtin_amdgcn_readfirstlane(tid >> 6), lane = tid & 63, wr = wid >> 2, wc = wid & 3, fr = lane & 15, fq = lane >> 4;
    const int nt = K / BK;
    int RA[2], CA[2];
    unsigned voffB[2], vA[2][2], nvA[2][2];
#pragma unroll
    for (int i = 0; i < 2; ++i) { int R, C; stage_rc(tid * 16 + i * 8192, R, C); const int Rb = Epi::PERM ? ((R & ~31) + perm32(R & 31)) : R;
        RA[i] = R; CA[i] = C; voffB[i] = (unsigned)(Rb * ldb + C) * 2u; }
    const size_t kstep = (size_t)(BK * 2);
    const size_t hstepB = (size_t)HALF * ldb * 2;
    const unsigned ldsw = (unsigned)wid * 1024u;
    const int aoff = lds_byte(wr * 64 + fr, fq * 8), boff = lds_byte(wc * 32 + fr, fq * 8);
#define PG8_SA(b, h) (((b) * 2 + (h)) * HTB)
#define PG8_SB(b, h) ((4 + (b) * 2 + (h)) * HTB)
#define PG8_STAGE(bufoff, gbase, voff) do { _Pragma("unroll") for (int _i = 0; _i < 2; ++_i) \
        __builtin_amdgcn_global_load_lds((const unsigned*)((const char*)(gbase) + (voff)[_i]), (LAS unsigned*)(lds + (bufoff) + ldsw + _i * 8192), 16, 0, 0); } while (0)
#define PG8_LDA(dst, b, h) do { _Pragma("unroll") for (int m = 0; m < 4; ++m) _Pragma("unroll") for (int k = 0; k < 2; ++k) dst[m][k] = *(const LAS bf16x8*)(lds + PG8_SA(b, h) + aoff + m * 2048 + k * 1024); } while (0)
#define PG8_LDB(dst, b, h) do { _Pragma("unroll") for (int n = 0; n < 2; ++n) _Pragma("unroll") for (int k = 0; k < 2; ++k) dst[n][k] = *(const LAS bf16x8*)(lds + PG8_SB(b, h) + boff + n * 2048 + k * 1024); } while (0)
#define PG8_MMA(ai, bj, At, Bt) do { __builtin_amdgcn_s_setprio(1); _Pragma("unroll") for (int m = 0; m < 4; ++m) _Pragma("unroll") for (int n = 0; n < 2; ++n) _Pragma("unroll") for (int k = 0; k < 2; ++k) \
        acc[ai][bj][m][n] = __builtin_amdgcn_mfma_f32_16x16x32_bf16(Bt[n][k], At[m][k], acc[ai][bj][m][n], 0, 0, 0); __builtin_amdgcn_s_setprio(0); } while (0)
#define PG8_WAIT_V(n) asm volatile("s_waitcnt vmcnt(" #n ")" ::: "memory")
#define PG8_WAIT_L(n) asm volatile("s_waitcnt lgkmcnt(" #n ")" ::: "memory")
#define PG8_BAR __builtin_amdgcn_s_barrier()
#define PG8_SCHED __builtin_amdgcn_sched_barrier(0)
#define PG8_SETVA(dst, u) do { _Pragma("unroll") for (int _h = 0; _h < 2; ++_h) _Pragma("unroll") for (int _i = 0; _i < 2; ++_i) { \
        if constexpr (GATHER) dst[_h][_i] = (unsigned)(S.arow(u, _h * HALF + RA[_i]) * (unsigned)lda + (unsigned)CA[_i]) * 2u; \
        else dst[_h][_i] = (unsigned)((_h * HALF + RA[_i]) * lda + CA[_i]) * 2u; } } while (0)
    Unit cur, nxt; int ui = 0;
    if (!S.next(0, cur)) return;
    PG8_SETVA(vA, cur);
#pragma unroll
    for (int h = 0; h < 2; ++h)
#pragma unroll
        for (int i = 0; i < 2; ++i) nvA[h][i] = vA[h][i];
    f32x4 acc[2][2][4][2];
#pragma unroll
    for (int a = 0; a < 2; ++a)
#pragma unroll
        for (int b = 0; b < 2; ++b)
#pragma unroll
            for (int m = 0; m < 4; ++m)
#pragma unroll
                for (int n = 0; n < 2; ++n) acc[a][b][m][n] = (f32x4){0.f, 0.f, 0.f, 0.f};
    bf16x8 At[4][2], B0[2][2], B1[2][2];
    const char* cA = cur.a; const char* cB = cur.b;
    PG8_STAGE(PG8_SB(0, 0), cB, voffB); PG8_STAGE(PG8_SB(0, 1), cB + hstepB, voffB); PG8_STAGE(PG8_SA(0, 0), cA, vA[0]); PG8_STAGE(PG8_SA(0, 1), cA, vA[1]);
    if (wr == 1) PG8_BAR;
    PG8_WAIT_V(2); PG8_BAR;
    PG8_STAGE(PG8_SB(1, 0), cB + kstep, voffB); PG8_STAGE(PG8_SA(1, 0), cA + kstep, vA[0]); PG8_STAGE(PG8_SB(1, 1), cB + hstepB + kstep, voffB);
    PG8_WAIT_V(6); PG8_BAR;
    for (;;) {
        const bool has_next = S.next(ui + 1, nxt);
        const char* nA = has_next ? nxt.a : cA; const char* nB = has_next ? nxt.b : cB;
        if constexpr (GATHER) { if (has_next) PG8_SETVA(nvA, nxt); }
        const int jt = cur.jt; const long jb = (long)cur.jb;
        for (int t = 0; t < nt; t += 2) {
            const bool last = (t == nt - 2);
            const char* a1 = cA + (size_t)(t + 1) * kstep;
            const char* a2 = last ? nA : cA + (size_t)(t + 2) * kstep;
            const char* b2 = last ? nB : cB + (size_t)(t + 2) * kstep + ((t + 2) >= jt ? jb : 0l);
            const char* a3 = a2 + kstep;
            const char* b3 = last ? nB + kstep : cB + (size_t)(t + 3) * kstep + ((t + 3) >= jt ? jb : 0l);
            unsigned w0[2], w1[2];
            if constexpr (GATHER) { w0[0] = last ? nvA[0][0] : vA[0][0]; w0[1] = last ? nvA[0][1] : vA[0][1]; w1[0] = last ? nvA[1][0] : vA[1][0]; w1[1] = last ? nvA[1][1] : vA[1][1]; }
            else { w0[0] = vA[0][0]; w0[1] = vA[0][1]; w1[0] = vA[1][0]; w1[1] = vA[1][1]; }
            PG8_LDB(B0, 0, 0); PG8_LDB(B1, 0, 1); PG8_SCHED; PG8_LDA(At, 0, 0); PG8_STAGE(PG8_SA(1, 1), a1, vA[1]);
            PG8_WAIT_V(8); PG8_WAIT_L(0); PG8_BAR; PG8_MMA(0, 0, At, B0); PG8_MMA(0, 1, At, B1); PG8_BAR; PG8_SCHED;
            PG8_LDA(At, 0, 1); PG8_STAGE(PG8_SB(0, 0), b2, voffB); PG8_STAGE(PG8_SB(0, 1), b2 + hstepB, voffB); PG8_STAGE(PG8_SA(0, 0), a2, w0);
            PG8_WAIT_V(8); PG8_WAIT_L(0); PG8_BAR; PG8_MMA(1, 0, At, B0); PG8_MMA(1, 1, At, B1); PG8_BAR; PG8_SCHED;
            PG8_LDB(B0, 1, 0); PG8_LDB(B1, 1, 1); PG8_SCHED; PG8_LDA(At, 1, 0); PG8_STAGE(PG8_SA(0, 1), a2, w1);
            PG8_WAIT_V(8); PG8_WAIT_L(0); PG8_BAR; PG8_MMA(0, 0, At, B0); PG8_MMA(0, 1, At, B1); PG8_BAR; PG8_SCHED;
            PG8_LDA(At, 1, 1); PG8_STAGE(PG8_SB(1, 0), b3, voffB); PG8_STAGE(PG8_SB(1, 1), b3 + hstepB, voffB); PG8_STAGE(PG8_SA(1, 0), a3, w0);
            PG8_WAIT_V(8); PG8_WAIT_L(0); PG8_BAR; PG8_MMA(1, 0, At, B0); PG8_MMA(1, 1, At, B1); PG8_BAR; PG8_SCHED;
        }
        if (wr == 0) PG8_BAR;
        E(acc, cur, wr, wc, fr, fq);
        if (!has_next) break;
#pragma unroll
        for (int a = 0; a < 2; ++a)
#pragma unroll
            for (int b = 0; b < 2; ++b)
#pragma unroll
                for (int m = 0; m < 4; ++m)
#pragma unroll
                    for (int n = 0; n < 2; ++n) acc[a][b][m][n] = (f32x4){0.f, 0.f, 0.f, 0.f};
        cur = nxt; cA = nA; cB = nB; ++ui;
        if constexpr (GATHER) {
#pragma unroll
            for (int h = 0; h < 2; ++h)
#pragma unroll
                for (int i = 0; i < 2; ++i) vA[h][i] = nvA[h][i];
        }
        if (wr == 1) PG8_BAR;
    }
    PG8_WAIT_V(0);
    PG8_BAR;
#undef PG8_SA
#undef PG8_SB
#undef PG8_STAGE
#undef PG8_LDA
#undef PG8_LDB
#undef PG8_MMA
#undef PG8_WAIT_V
#undef PG8_WAIT_L
#undef PG8_BAR
#undef PG8_SCHED
#undef PG8_SETVA
}
}

constexpr size_t MiB = 1u << 20;
constexpr size_t WS_CTL = 0, CTL_ZERO_BYTES = 1 * MiB;
constexpr size_t WS_MISC = 1 * MiB;
constexpr size_t WS_WQKV = 4 * MiB;
constexpr size_t WS_WO   = 10 * MiB;
constexpr size_t WS_WFI  = 12 * MiB;
constexpr size_t WS_WFO  = 16 * MiB;
constexpr size_t WS_WGU  = 18 * MiB;
constexpr size_t WS_WD   = 82 * MiB;
constexpr size_t WS_X    = 114 * MiB;
constexpr size_t WS_H    = 178 * MiB;
constexpr size_t WS_R    = 210 * MiB;
constexpr size_t WS_Q = WS_R, WS_K = WS_R + 32 * MiB, WS_V = WS_R + 64 * MiB;
constexpr size_t WS_HID = WS_R;
constexpr size_t WS_ZT = WS_R;
constexpr size_t WS_FT = WS_R + 64 * MiB;
constexpr size_t WS_AUG = 306 * MiB;
constexpr size_t WS_END = 307 * MiB;
constexpr size_t MS_MOD = 0;
constexpr size_t MS_TW  = 128 * 1024;
constexpr size_t MS_RW  = 256 * 1024;
constexpr size_t WS_LIST = 2 * MiB;
constexpr int CW_TMO = 0;
constexpr int CW_CNT = 64;
constexpr int CW_NMAX = 4096;
constexpr int CW_QHEAD = 4608;
constexpr int CW_BAR = 8192;

constexpr int RING_BYTES = 131072;
constexpr int LDSCTL_OFF = RING_BYTES, MISC_OFF = LDSCTL_OFF + 320;
constexpr int LDS_BYTES = 147456;

#define RLX_AGENT __ATOMIC_RELAXED, __HIP_MEMORY_SCOPE_AGENT
#define LDS_WAIT() asm volatile("s_waitcnt lgkmcnt(0)" ::: "memory")
#define VM_WAIT() asm volatile("s_waitcnt vmcnt(0)" ::: "memory")

#define XB_TMO      128
#define XB_XCNT(j)  (256  + 64 * (j))
#define XB_XSUB(j)  (1280 + 64 * (j))
#define XB_XGEN(j)  (2304 + 64 * (j))
#define XB_TOP      3328
#define XB_TOPGEN   3392
#define XCD_BAR_WORDS 3456
#define XB_SPIN_CAP (1u << 22)
__device__ __forceinline__ unsigned xb_ld(unsigned* p)              { return __hip_atomic_load(p, __ATOMIC_RELAXED, __HIP_MEMORY_SCOPE_AGENT); }
__device__ __forceinline__ unsigned xb_add(unsigned* p, unsigned v) { return __hip_atomic_fetch_add(p, v, __ATOMIC_RELAXED, __HIP_MEMORY_SCOPE_AGENT); }
__device__ __forceinline__ unsigned xb_xcc_id() { return (unsigned)__builtin_amdgcn_s_getreg((3 << 11) | 20) & 0xFu; }
#define XB_SPIN(cond, bar) do { unsigned _sp = 0; while (cond) { __builtin_amdgcn_s_sleep(1); \
    if ((++_sp & 255u) == 0u) { if (xb_ld(&(bar)[XB_TMO])) break; if (_sp > XB_SPIN_CAP) { atomicAdd(&(bar)[XB_TMO], 1u); break; } } } } while (0)
struct XcdBarrier { unsigned* bar; unsigned x; volatile LAS unsigned* st; };
__device__ __forceinline__ XcdBarrier xcd_barrier_post(unsigned* bar, volatile LAS unsigned* st) {
    XcdBarrier b; b.bar = bar; b.x = xb_xcc_id(); b.st = st;
    if (threadIdx.x == 0) (void)xb_add(&bar[XB_XCNT(b.x)], 1u);
    return b;
}
__device__ __forceinline__ void xcd_barrier_complete(unsigned* bar, unsigned x, unsigned& nloc, unsigned& nx) {
    const unsigned G = gridDim.x * gridDim.y * gridDim.z;
    unsigned sum, cnt, mine, sp = 0u;
    for (;;) {
        sum = 0u; cnt = 0u; mine = 0u;
#pragma unroll
        for (unsigned j = 0; j < 16; ++j) { const unsigned c = xb_ld(&bar[XB_XCNT(j)]); sum += c; cnt += (c > 0u) ? 1u : 0u; mine = (j == x) ? c : mine; }
        if (sum == G) break;
        __builtin_amdgcn_s_sleep(1);
        if ((++sp & 255u) == 0u) { if (xb_ld(&bar[XB_TMO])) break; if (sp > XB_SPIN_CAP) { atomicAdd(&bar[XB_TMO], 1u); break; } }
    }
    nloc = mine > 0u ? mine : 1u; nx = cnt > 0u ? cnt : 1u;
}
__device__ __forceinline__ void xcd_barrier(const XcdBarrier& b) {
    asm volatile("s_waitcnt vmcnt(0)" ::: "memory");
    __syncthreads();
    if (threadIdx.x == 0) {
        unsigned* bar = b.bar;
        __builtin_amdgcn_s_waitcnt(0);
        unsigned nloc = b.st[0], nx = b.st[1];
        if (nloc == 0u) { xcd_barrier_complete(bar, b.x, nloc, nx); b.st[0] = nloc; b.st[1] = nx; }
        const unsigned old = xb_add(&bar[XB_XSUB(b.x)], 1u);
        const unsigned gen = old / nloc;
        if (old + 1u == (gen + 1u) * nloc) {
            __builtin_amdgcn_fence(__ATOMIC_RELEASE, "agent");
            asm volatile("s_waitcnt vmcnt(0)" ::: "memory");
            const unsigned og = xb_add(&bar[XB_TOP], 1u);
            const unsigned tg = og / nx;
            if (og + 1u == (tg + 1u) * nx) xb_add(&bar[XB_TOPGEN], 1u);
            else XB_SPIN(xb_ld(&bar[XB_TOPGEN]) == tg, bar);
            __builtin_amdgcn_fence(__ATOMIC_ACQUIRE, "agent");
            xb_add(&bar[XB_XGEN(b.x)], 1u);
            asm volatile("s_waitcnt vmcnt(0)" ::: "memory");
        } else {
            XB_SPIN(xb_ld(&bar[XB_XGEN(b.x)]) == gen, bar);
            __builtin_amdgcn_fence(__ATOMIC_ACQUIRE, "agent");
            asm volatile("s_waitcnt vmcnt(0)" ::: "memory");
        }
    }
    __syncthreads();
}

struct Args {
    const float* in[23];
    float* out; unsigned char* ws;
    int ph_lo, ph_hi;
};
enum InIdx { I_X = 0, I_C, I_ADAW, I_ADAB, I_NMIX, I_NFFN, I_AWIN, I_LQ1, I_LK1, I_LQ2, I_LK2, I_SUBLN, I_AWOUT, I_FWIN, I_FWOUT, I_RGW, I_RGB, I_REW, I_REB, I_EWG, I_EWU, I_EWD, I_NFIN };

struct Frame {
    LAS unsigned char* lds;
    gu32* ctl;
    int tid, lane, wave, vcu, G;
    unsigned char* ws;
};

__device__ __forceinline__ void tr_item(const float* W, int ldw, int k0, int n0, bf16_t* WT, int ldt, int r0, int c0, LAS float* scr, int lane) {
#pragma unroll 8
    for (int i = 0; i < 32; ++i) { const int kk = 2 * i + (lane >> 5); scr[kk * 33 + (lane & 31)] = W[(size_t)(k0 + kk) * ldw + n0 + (lane & 31)]; }
    LDS_WAIT(); asm volatile("" ::: "memory");
    const int c = lane & 7;
#pragma unroll
    for (int j = 0; j < 4; ++j) { const int n = (lane >> 3) + 8 * j; const LAS float* s = scr + (8 * c) * 33 + n;
        u32x4 o; o.x = pk2(s[0 * 33], s[1 * 33]); o.y = pk2(s[2 * 33], s[3 * 33]); o.z = pk2(s[4 * 33], s[5 * 33]); o.w = pk2(s[6 * 33], s[7 * 33]);
        *(GAS u32x4*)(WT + (size_t)(r0 + n) * ldt + c0 + 8 * c) = o; }
    LDS_WAIT(); asm volatile("" ::: "memory");
}
__device__ __forceinline__ void fold_item(const float* win, bf16_t* WT, int item, LAS float* scr, const LAS float* tab, int lane) {
    const int nb = item >> 5, kb = item & 31, n0 = nb * 32, k0 = kb * 32;
    const int part = n0 >> 10, g = (n0 >> 8) & 3, l0 = n0 & 255;
    const LAS float* tb = tab + part * 256;
    LAS float* wt = scr; LAS float* tt = scr + 1152;
    const int kq = lane >> 3, lq = lane & 7;
    f32x4 acc[4];
#pragma unroll
    for (int i = 0; i < 4; ++i) acc[i] = (f32x4){0.f, 0.f, 0.f, 0.f};
    for (int c0 = 0; c0 < 256; c0 += 32) {
#pragma unroll 4
        for (int i = 0; i < 16; ++i) { const int kk = 2 * i + (lane >> 5), cc = lane & 31; wt[cc * 36 + kk] = win[(size_t)(k0 + kk) * 1024 + g * 256 + c0 + cc]; }
#pragma unroll 4
        for (int i = 0; i < 16; ++i) { const int cc = 2 * i + (lane >> 5), l = lane & 31; tt[cc * 36 + l] = tb[((l0 + l) * (c0 + cc)) & 255]; }
        LDS_WAIT(); asm volatile("" ::: "memory");
#pragma unroll 8
        for (int cc = 0; cc < 32; ++cc) { const f32x4 w = *(const LAS f32x4*)(wt + cc * 36 + 4 * kq); const f32x4 t = *(const LAS f32x4*)(tt + cc * 36 + 4 * lq);
            acc[0] += t * w.x; acc[1] += t * w.y; acc[2] += t * w.z; acc[3] += t * w.w; }
        LDS_WAIT(); asm volatile("" ::: "memory");
    }
#pragma unroll
    for (int i = 0; i < 4; ++i)
#pragma unroll
        for (int j = 0; j < 4; ++j) wt[(4 * lq + j) * 36 + 4 * kq + i] = acc[i][j] * 0.0625f;
    LDS_WAIT(); asm volatile("" ::: "memory");
    { const int n = lane >> 1, kh = (lane & 1) * 16; const LAS float* s = wt + n * 36 + kh;
      u32x4 o0, o1; o0.x = pk2(s[0], s[1]); o0.y = pk2(s[2], s[3]); o0.z = pk2(s[4], s[5]); o0.w = pk2(s[6], s[7]); o1.x = pk2(s[8], s[9]); o1.y = pk2(s[10], s[11]); o1.z = pk2(s[12], s[13]); o1.w = pk2(s[14], s[15]);
      GAS u32x4* d = (GAS u32x4*)(WT + (size_t)(n0 + n) * 1024 + k0 + kh); d[0] = o0; d[1] = o1; }
    LDS_WAIT(); asm volatile("" ::: "memory");
}

__device__ __forceinline__ void p0_prologue(Frame& F, const Args& A) {
    unsigned char* ws = F.ws;
    float* mod = (float*)(ws + WS_MISC + MS_MOD);
    LAS float* silu_c = (LAS float*)(F.lds + 112 * 1024);
    LAS float* tab = (LAS float*)(F.lds + 120 * 1024);
    LAS float* part = (LAS float*)(F.lds + 124 * 1024);
    { const int gid = blockIdx.x * NTHREADS + F.tid; if (gid < 8192) { float sv, cv; sincospif((float)gid * (1.0f / 4096.0f), &sv, &cv); float* tw = (float*)(ws + WS_MISC + MS_TW); tw[gid] = cv; tw[8192 + gid] = sv; } }
    { const int gid = blockIdx.x * NTHREADS + F.tid; if (gid < 65536) { const int head = gid >> 13, pos = gid & 8191; const float t = exp2f(-(float)(head + 1)) * LOG2E * (float)pos;
        const unsigned t1 = f2bf(t); const float r1 = t - __builtin_bit_cast(float, t1 << 16); const unsigned t2 = f2bf(r1); const float r2 = r1 - __builtin_bit_cast(float, t2 << 16); const unsigned t3 = f2bf(r2);
        u32x4 w; w.x = 0x3f803f80u; w.y = 0x3f80u | (t1 << 16); w.z = t2 | (t3 << 16); w.w = 0u; ((u32x4*)(ws + WS_AUG))[gid] = w; } }
    if (F.tid < 256) { float sv, cv; sincospif((float)F.tid * (1.0f / 128.0f), &sv, &cv); tab[F.tid] = cv; tab[256 + F.tid] = sv; }
    for (int i = F.tid; i < 2048; i += NTHREADS) { const float v = A.in[I_C][i]; silu_c[i] = v / (1.f + __expf(-v)); }
    __syncthreads();
    for (int item = blockIdx.x; item < 192; item += F.G) {
        const int l = item / 96, cb = item % 96;
        const float* W = A.in[I_ADAW] + (size_t)l * 1024 * 6144 + cb * 64;
        const int cg = F.lane & 15, rs = F.lane >> 4;
        f32x4 a0 = (f32x4){0.f, 0.f, 0.f, 0.f}, a1 = a0;
#pragma unroll 8
        for (int i = 0; i < 32; ++i) { const int row = F.wave * 128 + i * 4 + rs; const f32x4 w = *(const f32x4*)(W + (size_t)row * 6144 + cg * 4); a0 += w * silu_c[row]; a1 += w * silu_c[1024 + row]; }
#pragma unroll
        for (int j = 0; j < 4; ++j) { a0[j] += __shfl_xor(a0[j], 16); a0[j] += __shfl_xor(a0[j], 32); a1[j] += __shfl_xor(a1[j], 16); a1[j] += __shfl_xor(a1[j], 32); }
        if (rs == 0) { *(LAS f32x4*)(part + (F.wave * 2 + 0) * 64 + cg * 4) = a0; *(LAS f32x4*)(part + (F.wave * 2 + 1) * 64 + cg * 4) = a1; }
        __syncthreads();
        if (F.tid < 128) { const int b = F.tid >> 6, col = F.tid & 63; float s = 0.f;
#pragma unroll
            for (int w = 0; w < 8; ++w) s += part[(w * 2 + b) * 64 + col];
            mod[(size_t)(l * 2 + b) * 6144 + cb * 64 + col] = s + A.in[I_ADAB][l * 6144 + cb * 64 + col]; }
        __syncthreads();
    }
    LAS float* scr = (LAS float*)(F.lds + F.wave * 12288);
    const int gw = F.vcu * NWAVES + F.wave, NGW = F.G * NWAVES;
    constexpr int I_QKV = 16 * 96, I_SQ = 16 * 32, I_GU = 2 * 16 * 2 * 256, I_DN = 2 * 16 * 256, I_FOLD = 64 * 32;
    constexpr int NITEMS = I_QKV + 2 * I_SQ + I_GU + I_DN + I_FOLD;
    for (int it = gw; it < NITEMS; it += NGW) {
        int r = it;
        if (r < I_FOLD) { fold_item(A.in[I_FWIN], (bf16_t*)(ws + WS_WFI), r, scr, tab, F.lane); continue; } r -= I_FOLD;
        if (r < I_QKV) { const int kb = r / 96, nb = r % 96; tr_item(A.in[I_AWIN], 3072, kb * 64, nb * 32, (bf16_t*)(ws + WS_WQKV), 1024, nb * 32, kb * 64, scr, F.lane); continue; } r -= I_QKV;
        if (r < I_SQ) { const int kb = r / 32, nb = r % 32; tr_item(A.in[I_AWOUT], 1024, kb * 64, nb * 32, (bf16_t*)(ws + WS_WO), 1024, nb * 32, kb * 64, scr, F.lane); continue; } r -= I_SQ;
        if (r < I_SQ) { const int kb = r / 32, nb = r % 32; tr_item(A.in[I_FWOUT], 1024, kb * 64, nb * 32, (bf16_t*)(ws + WS_WFO), 1024, nb * 32, kb * 64, scr, F.lane); continue; } r -= I_SQ;
        if (r < I_GU) { const int le = r >> 9, gu = (r >> 8) & 1, kb = (r >> 4) & 15, nb = r & 15, n0 = nb * 32;
            const float* src = (gu ? A.in[I_EWU] : A.in[I_EWG]) + (size_t)le * 1024 * 512;
            tr_item(src, 512, kb * 64, n0, (bf16_t*)(ws + WS_WGU) + (size_t)le * 1024 * 1024, 1024, (n0 >> 7) * 256 + gu * 128 + (n0 & 127), kb * 64, scr, F.lane); continue; } r -= I_GU;
        { const int le = r >> 8, kb = (r >> 5) & 7, nb = r & 31, lg = le >> 2, el = le & 3;
            const float* src = A.in[I_EWD] + (size_t)le * 512 * 1024;
            tr_item(src, 1024, kb * 64, nb * 32, (bf16_t*)(ws + WS_WD) + (size_t)lg * 1024 * 2048, 2048, nb * 32, el * 512 + kb * 64, scr, F.lane); }
    }
}

__device__ __forceinline__ void ld_row(const float* row, int lane, f32x4 (&v)[4]) {
    const GAS f32x4* xr = (const GAS f32x4*)row + lane;
#pragma unroll
    for (int j = 0; j < 4; ++j) v[j] = xr[64 * j];
}
__device__ __forceinline__ float row_rstd(const f32x4 (&v)[4]) {
    float s = 0.f;
#pragma unroll
    for (int j = 0; j < 4; ++j) s += (v[j].x * v[j].x + v[j].y * v[j].y) + (v[j].z * v[j].z + v[j].w * v[j].w);
    return 1.0f / sqrtf(wave_sum(s) * (1.0f / DM) + EPS);
}
__device__ __forceinline__ void norm_pass(Frame& F, const float* x, const float* g, const float* modl  , int sh_off, int sc_off, bf16_t* outb, float* outf) {
    const int gw = F.vcu * NWAVES + F.wave, NGW = F.G * NWAVES;
    f32x4 gv[4];
#pragma unroll
    for (int j = 0; j < 4; ++j) gv[j] = *((const GAS f32x4*)g + F.lane + 64 * j);
    for (int m = gw; m < TOK; m += NGW) {
        f32x4 v[4]; ld_row(x + (size_t)m * DM, F.lane, v);
        const float rstd = row_rstd(v);
        if (outb) {
            const float* mb = modl + (size_t)(m >> 13) * 6144;
            GAS u32x2* o8 = (GAS u32x2*)(outb + (size_t)m * DM) + F.lane;
#pragma unroll
            for (int j = 0; j < 4; ++j) { const f32x4 sh = *((const GAS f32x4*)(mb + sh_off) + F.lane + 64 * j), sc = *((const GAS f32x4*)(mb + sc_off) + F.lane + 64 * j);
                const f32x4 h = v[j] * rstd * gv[j] * (sc + 1.0f) + sh; u32x2 w; w.x = pk2(h.x, h.y); w.y = pk2(h.z, h.w); o8[64 * j] = w; }
        } else {
            GAS f32x4* o = (GAS f32x4*)(outf + (size_t)m * DM) + F.lane;
#pragma unroll
            for (int j = 0; j < 4; ++j) o[64 * j] = v[j] * rstd * gv[j];
        }
    }
}

struct DenseSched {
    int nM, nN, nwg, G, c; const char* A; const char* B; size_t tA, tB;
    __device__ void init(const void* A_, const void* B_, int M, int N, int lda, int ldb, int G_, int c_) { nM = M / 256; nN = N / 256; nwg = nM * nN; G = G_; c = c_; A = (const char*)A_; B = (const char*)B_; tA = (size_t)256 * lda * 2; tB = (size_t)256 * ldb * 2; }
    __device__ __forceinline__ bool next(int i, pg8::Unit& u) const {
        const long L = (long)i * G + c; if (L >= nwg) return false;
        int wgid = (int)L; { const int q = nwg / 8, r = nwg % 8, xcd = wgid % 8, off = wgid / 8; wgid = (xcd < r ? xcd * (q + 1) : r * (q + 1) + (xcd - r) * q) + off; }
        const int nig = 8 * nN, gid = wgid / nig, fm = gid * 8, gsz = (nM - fm) < 8 ? (nM - fm) : 8;
        u.pm = fm + ((wgid % nig) % gsz); u.pn = (wgid % nig) / gsz;
        u.a = A + (size_t)u.pm * tA; u.b = B + (size_t)u.pn * tB; u.jt = 1 << 30; u.jb = 0; u.aux0 = 0; u.aux1 = 0; return true;
    }
    __device__ __forceinline__ unsigned arow(const pg8::Unit&, int) const { return 0u; }
};
struct EpiBf16 {
    static constexpr bool PERM = true;
    bf16_t* O; int ldc; int split_cols; size_t split_stride; float scale0;
    __device__ __forceinline__ void operator()(const f32x4 (&acc)[2][2][4][2], const pg8::Unit& u, int wr, int wc, int fr, int fq) const {
        const int row0 = u.pm * 256 + wr * 64 + fr; int colt = u.pn * 256; bf16_t* base = O;
        float sc = 1.f; if (split_cols) { const int t = colt / split_cols; base += (size_t)t * split_stride; colt -= t * split_cols; if (t == 0) sc = scale0; }
        const int col0 = colt + wc * 32 + 8 * fq;
#pragma unroll
        for (int ai = 0; ai < 2; ++ai)
#pragma unroll
            for (int m = 0; m < 4; ++m) { bf16_t* rowp = base + (size_t)(row0 + ai * 128 + m * 16) * ldc + col0;
#pragma unroll
                for (int bj = 0; bj < 2; ++bj) { const f32x4 v0 = acc[ai][bj][m][0] * sc, v1 = acc[ai][bj][m][1] * sc;
                    u32x4 w; w.x = cvt_pk_bf16(v0[0], v0[1]); w.y = cvt_pk_bf16(v0[2], v0[3]); w.z = cvt_pk_bf16(v1[0], v1[1]); w.w = cvt_pk_bf16(v1[2], v1[3]);
                    *(u32x4*)(rowp + bj * 128) = w; } }
    }
};
struct EpiQKV {
    static constexpr bool PERM = true;
    bf16_t* O; size_t split_stride; float scale0; unsigned* nmax;
    __device__ __forceinline__ void operator()(const f32x4 (&acc)[2][2][4][2], const pg8::Unit& u, int wr, int wc, int fr, int fq) const {
        const int t = u.pn >> 2, colt = (u.pn & 3) * 256; bf16_t* base = O + (size_t)t * split_stride; const float sc = t == 0 ? scale0 : 1.f;
        const int row0 = u.pm * 256 + wr * 64 + fr, col0 = colt + wc * 32 + 8 * fq;
        float mx[2] = {0.f, 0.f};
#pragma unroll
        for (int ai = 0; ai < 2; ++ai)
#pragma unroll
            for (int m = 0; m < 4; ++m) { bf16_t* rowp = base + (size_t)(row0 + ai * 128 + m * 16) * 1024 + col0;
#pragma unroll
                for (int bj = 0; bj < 2; ++bj) { const f32x4 v0 = acc[ai][bj][m][0] * sc, v1 = acc[ai][bj][m][1] * sc;
                    u32x4 w; w.x = cvt_pk_bf16(v0[0], v0[1]); w.y = cvt_pk_bf16(v0[2], v0[3]); w.z = cvt_pk_bf16(v1[0], v1[1]); w.w = cvt_pk_bf16(v1[2], v1[3]);
                    *(u32x4*)(rowp + bj * 128) = w;
                    if (t < 2) { float ss = (v0[0] * v0[0] + v0[1] * v0[1]) + (v0[2] * v0[2] + v0[3] * v0[3]) + (v1[0] * v1[0] + v1[1] * v1[1]) + (v1[2] * v1[2] + v1[3] * v1[3]);
                        ss += __shfl_xor(ss, 16); ss += __shfl_xor(ss, 32); mx[bj] = fmaxf(mx[bj], ss); } } }
        if (t < 2) {
#pragma unroll
            for (int bj = 0; bj < 2; ++bj) { float v = mx[bj]; v = fmaxf(v, __shfl_xor(v, 1)); v = fmaxf(v, __shfl_xor(v, 2)); v = fmaxf(v, __shfl_xor(v, 4)); v = fmaxf(v, __shfl_xor(v, 8));
                if ((threadIdx.x & 63) == 0) { const int b = (u.pm * 256) >> 13, map = (u.pn & 3) * 4 + bj * 2 + (wc >> 1);
                    atomicMax(nmax + ((t * 2 + b) * 16 + map) * 2 + (wc & 1), __float_as_uint(v)); } }
        }
    }
};
struct EpiRes {
    static constexpr bool PERM = false;
    const float* xin; float* xout; const float* gate  ; int g_off;
    __device__ __forceinline__ void operator()(const f32x4 (&acc)[2][2][4][2], const pg8::Unit& u, int wr, int wc, int fr, int fq) const {
        const int row0 = u.pm * 256 + wr * 64 + fr, col0 = u.pn * 256 + wc * 32 + 4 * fq;
        const float* gb = gate + (size_t)((u.pm * 256) >> 13) * 6144 + g_off + col0;
        f32x4 gv[2][2];
#pragma unroll
        for (int bj = 0; bj < 2; ++bj)
#pragma unroll
            for (int n = 0; n < 2; ++n) gv[bj][n] = *(const f32x4*)(gb + bj * 128 + n * 16);
#pragma unroll
        for (int ai = 0; ai < 2; ++ai)
#pragma unroll
            for (int m = 0; m < 4; ++m) { const size_t off = (size_t)(row0 + ai * 128 + m * 16) * DM + col0;
#pragma unroll
                for (int bj = 0; bj < 2; ++bj)
#pragma unroll
                    for (int n = 0; n < 2; ++n) { const f32x4 xi = *(const f32x4*)(xin + off + bj * 128 + n * 16); *(f32x4*)(xout + off + bj * 128 + n * 16) = xi + gv[bj][n] * acc[ai][bj][m][n]; } }
    }
};

struct MoeTab { const LAS int* cnt; const LAS int* mts; };
__device__ __forceinline__ void pair_of(int pid, int& lo, int& hi) { lo = pid < 3 ? 0 : (pid < 5 ? 1 : 2); hi = pid < 3 ? pid + 1 : (pid < 5 ? pid - 1 : 3); }
__device__ __forceinline__ void moe_build_tab(Frame& F, const gu32* cntw, LAS int* tab) {
    __syncthreads();
    if (F.tid == 0) { int s = 0;
        for (int b = 0; b < NBUCKET; ++b) { const int c = (int)__hip_atomic_load(cntw + 64 * b, RLX_AGENT); tab[b] = c; tab[32 + b] = s; s += (c + 255) >> 8; }
        tab[32 + NBUCKET] = s; }
    __syncthreads();
}
struct Moe1Sched {
    const LAS int* tab; const int* list; const char* H; const char* W; int G, c;
    __device__ __forceinline__ bool next(int i, pg8::Unit& u) const {
        const int MT = tab[32 + NBUCKET], U = MT * 8; const long L = (long)i * G + c; if (L >= U) return false;
        const int wgid = (int)(L % 8) * MT + (int)(L / 8);
        const int mtg = wgid >> 3, nt = wgid & 7; int b = 0;
#pragma unroll 1
        for (int k = 1; k < NBUCKET; ++k) b = (tab[32 + k] <= mtg) ? k : b;
        const int g = b / 6; int lo, hi; pair_of(b % 6, lo, hi);
        const int e = g * 4 + ((nt >> 2) ? hi : lo), fb = nt & 3;
        u.pm = mtg; u.pn = nt; u.a = H; u.b = W + ((size_t)e * 1024 + fb * 256) * 1024 * 2; u.jt = 1 << 30; u.jb = 0; u.aux0 = b; u.aux1 = mtg - tab[32 + b]; return true;
    }
    __device__ __forceinline__ unsigned arow(const pg8::Unit& u, int r) const { const int idx = u.aux1 * 256 + r, c = tab[u.aux0]; return (unsigned)list[u.aux0 * 16384 + (idx < c ? idx : 0)]; }
};
struct Moe2Sched {
    const LAS int* tab; const char* HID; const char* W; int G, c;
    __device__ __forceinline__ bool next(int i, pg8::Unit& u) const {
        const int MT = tab[32 + NBUCKET], U = MT * 4; const long L = (long)i * G + c; if (L >= U) return false;
        int wgid = (int)L; { const int q = U / 8, r = U % 8, xcd = wgid % 8, off = wgid / 8; wgid = (xcd < r ? xcd * (q + 1) : r * (q + 1) + (xcd - r) * q) + off; }
        const int mtg = wgid >> 2, nt = wgid & 3; int b = 0;
#pragma unroll 1
        for (int k = 1; k < NBUCKET; ++k) b = (tab[32 + k] <= mtg) ? k : b;
        const int g = b / 6; int lo, hi; pair_of(b % 6, lo, hi);
        u.pm = mtg; u.pn = nt; u.a = HID + (size_t)mtg * 256 * 1024 * 2; u.b = W + (((size_t)g * 1024 + nt * 256) * 2048 + lo * 512) * 2; u.jt = 8; u.jb = (hi - lo - 1) * 512 * 2; u.aux0 = b; u.aux1 = mtg - tab[32 + b]; return true;
    }
    __device__ __forceinline__ unsigned arow(const pg8::Unit&, int) const { return 0u; }
};
struct EpiSwiGLU {
    static constexpr bool PERM = true;
    bf16_t* hid; const LAS int* tab; const int* list; const float* rw;
    __device__ __forceinline__ void operator()(const f32x4 (&acc)[2][2][4][2], const pg8::Unit& u, int wr, int wc, int fr, int fq) const {
        const int slot = u.pn >> 2, fb = u.pn & 3, cnt = tab[u.aux0];
#pragma unroll
        for (int ai = 0; ai < 2; ++ai)
#pragma unroll
            for (int m = 0; m < 4; ++m) { const int r = ai * 128 + wr * 64 + m * 16 + fr, idx = u.aux1 * 256 + r; const bool ok = idx < cnt;
                const int tok = list[u.aux0 * 16384 + (ok ? idx : 0)]; const float w = ok ? rw[tok * 2 + slot] : 0.f;
                float o[8];
#pragma unroll
                for (int n = 0; n < 2; ++n)
#pragma unroll
                    for (int j = 0; j < 4; ++j) { const float gt = acc[ai][0][m][n][j], up = acc[ai][1][m][n][j]; o[n * 4 + j] = gt * __builtin_amdgcn_rcpf(1.f + __builtin_amdgcn_exp2f(-gt * LOG2E)) * up * w; }
                u32x4 v; v.x = cvt_pk_bf16(o[0], o[1]); v.y = cvt_pk_bf16(o[2], o[3]); v.z = cvt_pk_bf16(o[4], o[5]); v.w = cvt_pk_bf16(o[6], o[7]);
                *(u32x4*)(hid + (size_t)(u.pm * 256 + r) * 1024 + slot * 512 + fb * 128 + wc * 32 + 8 * fq) = v; }
    }
};
struct EpiMoe2 {
    static constexpr bool PERM = false;
    float* x; const LAS int* tab; const int* list; const float* gate; int g_off;
    __device__ __forceinline__ void operator()(const f32x4 (&acc)[2][2][4][2], const pg8::Unit& u, int wr, int wc, int fr, int fq) const {
        const int cnt = tab[u.aux0], col0 = u.pn * 256 + wc * 32 + 4 * fq;
#pragma unroll
        for (int ai = 0; ai < 2; ++ai)
#pragma unroll
            for (int m = 0; m < 4; ++m) { const int r = ai * 128 + wr * 64 + m * 16 + fr, idx = u.aux1 * 256 + r;
                if (idx < cnt) { const int tok = list[u.aux0 * 16384 + idx]; const float* gb = gate + (size_t)(tok >> 13) * 6144 + g_off + col0; float* xr = x + (size_t)tok * DM + col0;
#pragma unroll
                    for (int bj = 0; bj < 2; ++bj)
#pragma unroll
                        for (int n = 0; n < 2; ++n) { const f32x4 gv = *(const f32x4*)(gb + bj * 128 + n * 16); f32x4* p = (f32x4*)(xr + bj * 128 + n * 16); *p = *p + gv * acc[ai][bj][m][n]; } } }
    }
};

namespace attn {
constexpr int QBLK = 32, KVBLK = 64, LD = 1024;
constexpr int SHM_V = KVBLK * DV * 2, SHM_K = KVBLK * DH * 2;
constexpr int SHM_A = KVBLK * 16;
constexpr int LDS_TOTAL = 2 * SHM_V + 2 * SHM_K + NWAVES * 64 * 4;
constexpr float THR = 11.5f;
#define AT_KSWZ(row, colB) ((row) * 128 + ((colB) ^ ((((row) >> 1) & 7) << 4)))
#define AT_SBAR() __builtin_amdgcn_sched_barrier(0)
__device__ __forceinline__ int crow(int r, int hi) { return (r & 3) + 8 * (r >> 2) + 4 * hi; }
__device__ __forceinline__ void partialSM(f32x16& p0, f32x16& p1, float& m_reg, float& alpha, bool& moved) {
    float pmax = p0[0];
#pragma unroll
    for (int r = 1; r < 16; ++r) pmax = fmaxf(pmax, p0[r]);
#pragma unroll
    for (int r = 0; r < 16; ++r) pmax = fmaxf(pmax, p1[r]);
    { auto rr = __builtin_amdgcn_permlane32_swap(__float_as_uint(pmax), __float_as_uint(pmax), false, false); pmax = fmaxf(__uint_as_float(rr[0]), __uint_as_float(rr[1])); }
    if (__builtin_expect(__all(pmax <= THR), 1)) { alpha = 1.f; moved = false; }
    else { const float dl = fmaxf(pmax, 0.f); m_reg += dl; alpha = __builtin_amdgcn_exp2f(-dl); moved = true;
#pragma unroll
        for (int r = 0; r < 16; ++r) { p0[r] -= dl; p1[r] -= dl; } }
#pragma unroll
    for (int r = 0; r < 16; ++r) p0[r] = __builtin_amdgcn_exp2f(p0[r]);
}
__device__ __forceinline__ void finishSM(f32x16& p0, f32x16& p1, float alpha, float& l_reg, bf16x8& pa0, bf16x8& pa1, bf16x8& pa2, bf16x8& pa3) {
#pragma unroll
    for (int r = 0; r < 16; ++r) p1[r] = __builtin_amdgcn_exp2f(p1[r]);
    float ps = 0;
#pragma unroll
    for (int r = 0; r < 16; ++r) ps += p0[r];
#pragma unroll
    for (int r = 0; r < 16; ++r) ps += p1[r];
    { auto rr = __builtin_amdgcn_permlane32_swap(__float_as_uint(ps), __float_as_uint(ps), false, false); ps = __uint_as_float(rr[0]) + __uint_as_float(rr[1]); }
    l_reg = l_reg * alpha + ps;
#define AT_PK4(P, BASE, OUT) do { unsigned a0 = cvt_pk_bf16(P[BASE + 0], P[BASE + 1]), a1 = cvt_pk_bf16(P[BASE + 2], P[BASE + 3]);   \
    unsigned b0 = cvt_pk_bf16(P[BASE + 4], P[BASE + 5]), b1 = cvt_pk_bf16(P[BASE + 6], P[BASE + 7]);                              \
    auto r0 = __builtin_amdgcn_permlane32_swap(a0, b0, false, false); auto r1 = __builtin_amdgcn_permlane32_swap(a1, b1, false, false); \
    u32x4 w = {r0[0], r1[0], r0[1], r1[1]}; OUT = __builtin_bit_cast(bf16x8, w); } while (0)
    AT_PK4(p0, 0, pa0); AT_PK4(p0, 8, pa1); AT_PK4(p1, 0, pa2); AT_PK4(p1, 8, pa3);
#undef AT_PK4
}
__device__ __forceinline__ void split3(float x, unsigned& b1, unsigned& b2, unsigned& b3) {
    b1 = cvt_pk_bf16(x, 0.f) & 0xffffu; const float r1 = x - __builtin_bit_cast(float, b1 << 16); b2 = cvt_pk_bf16(r1, 0.f) & 0xffffu; const float r2 = r1 - __builtin_bit_cast(float, b2 << 16); b3 = cvt_pk_bf16(r2, 0.f) & 0xffffu;
}
__device__ __forceinline__ bf16x8 build_qa(float a, unsigned coef  , int hi) {
    unsigned a1, a2, a3; split3(a, a1, a2, a3);
    u32x4 w; w.x = a1 | (a2 << 16); w.y = a3 | (coef << 16); w.z = coef | (coef << 16); w.w = 0u;
    if (hi) w = (u32x4){0u, 0u, 0u, 0u};
    return __builtin_bit_cast(bf16x8, w);
}
__device__ __forceinline__ void qkt(f32x16& p0, f32x16& p1, const LAS char* Ks, const bf16x8* qr, bf16x8 qa, bf16x8 ka0, bf16x8 ka1, int r32, int hi) {
    p0 = f32x16{}; p1 = f32x16{};
#pragma unroll
    for (int d0 = 0; d0 < 4; ++d0) { const int cb = (d0 * 16 + hi * 8) * 2;
        const bf16x8 b0 = *(const LAS bf16x8*)(Ks + AT_KSWZ(r32, cb));
        const bf16x8 b1 = *(const LAS bf16x8*)(Ks + AT_KSWZ(32 + r32, cb));
        p0 = __builtin_amdgcn_mfma_f32_32x32x16_bf16(b0, qr[d0], p0, 0, 0, 0);
        p1 = __builtin_amdgcn_mfma_f32_32x32x16_bf16(b1, qr[d0], p1, 0, 0, 0); }
    p0 = __builtin_amdgcn_mfma_f32_32x32x16_bf16(ka0, qa, p0, 0, 0, 0);
    p1 = __builtin_amdgcn_mfma_f32_32x32x16_bf16(ka1, qa, p1, 0, 0, 0);
}
__device__ __forceinline__ void add_abs_bias(f32x16& p0, f32x16& p1, float dpos  , float nslope) {
#pragma unroll
    for (int r = 0; r < 16; ++r) { const float c = (float)((r & 3) + 8 * (r >> 2)); p0[r] = fmaf(nslope, fabsf(dpos - c), p0[r]); p1[r] = fmaf(nslope, fabsf(dpos - (c + 32.f)), p1[r]); }
}
__device__ __forceinline__ int v_st(int k, int c) { const int kk = (k & ~0xC) | ((k & 4) << 1) | ((k & 8) >> 1); return ((kk >> 3) * 4 + (c >> 5)) * 512 + ((kk & 7) * 32 + (c & 31)) * 2; }
__device__ __forceinline__ int v_rd_base(int lane) { return ((lane & 3) << 3) | (((lane >> 2) & 3) << 6) | (((lane >> 4) & 1) << 5) | (((lane >> 5) & 1) << 8); }
constexpr int v_rd_off(int d0, int ks, int half) { return d0 * 512 + ks * 4096 + half * 2048; }
template <int OFF> __device__ __forceinline__ s16x4 tr_read(int vb) { s16x4 r; asm volatile("ds_read_b64_tr_b16 %0, %1 offset:%2" : "=&v"(r) : "v"(vb), "i"(OFF) : "memory"); return r; }
template <int D0> __device__ __forceinline__ void pv_one(f32x16& od, int vb, bf16x8 pa0, bf16x8 pa1, bf16x8 pa2, bf16x8 pa3) {
    const s16x4 l0 = tr_read<v_rd_off(D0, 0, 0)>(vb), h0 = tr_read<v_rd_off(D0, 0, 1)>(vb), l1 = tr_read<v_rd_off(D0, 1, 0)>(vb), h1 = tr_read<v_rd_off(D0, 1, 1)>(vb);
    const s16x4 l2 = tr_read<v_rd_off(D0, 2, 0)>(vb), h2 = tr_read<v_rd_off(D0, 2, 1)>(vb), l3 = tr_read<v_rd_off(D0, 3, 0)>(vb), h3 = tr_read<v_rd_off(D0, 3, 1)>(vb);
    asm volatile("s_waitcnt lgkmcnt(0)" ::: "memory"); AT_SBAR();
#define AT_PK(L, H) (bf16x8){L[0], L[1], L[2], L[3], H[0], H[1], H[2], H[3]}
    od = __builtin_amdgcn_mfma_f32_32x32x16_bf16(pa0, AT_PK(l0, h0), od, 0, 0, 0);
    od = __builtin_amdgcn_mfma_f32_32x32x16_bf16(pa1, AT_PK(l1, h1), od, 0, 0, 0);
    od = __builtin_amdgcn_mfma_f32_32x32x16_bf16(pa2, AT_PK(l2, h2), od, 0, 0, 0);
    od = __builtin_amdgcn_mfma_f32_32x32x16_bf16(pa3, AT_PK(l3, h3), od, 0, 0, 0);
#undef AT_PK
}
__device__ __forceinline__ void pv_d0(f32x16* o, int vb, bf16x8 pa0, bf16x8 pa1, bf16x8 pa2, bf16x8 pa3) {
    pv_one<0>(o[0], vb, pa0, pa1, pa2, pa3); pv_one<1>(o[1], vb, pa0, pa1, pa2, pa3); pv_one<2>(o[2], vb, pa0, pa1, pa2, pa3); pv_one<3>(o[3], vb, pa0, pa1, pa2, pa3);
}
__device__ __forceinline__ void unit(const bf16_t* __restrict__ Qh, const bf16_t* __restrict__ Kh, const bf16_t* __restrict__ Vh, bf16_t* __restrict__ Oh, int q0, float slope2, int tlo, int NT  , LAS char* lds) {
    int tid = threadIdx.x; asm volatile("" : "+v"(tid));
    const int wid = __builtin_amdgcn_readfirstlane(tid >> 6), lane = tid & 63, r32 = lane & 31, hi = lane >> 5;
    LAS char* V_lds = lds; LAS char* K_lds = lds + 2 * SHM_V;
    LAS float* ws = (LAS float*)(lds + 2 * SHM_V + 2 * SHM_K) + wid * 64; LAS float* li_l = ws; LAS float* al_l = ws + 32;
    float m_reg = 0.f, l_reg = 0; f32x16 o[4] = {}; bf16x8 qr[4];
    const bf16_t* Qw = Qh + (size_t)(q0 + wid * QBLK + r32) * LD + hi * 8;
#pragma unroll
    for (int d0 = 0; d0 < 4; ++d0) qr[d0] = *(const bf16x8*)(Qw + d0 * 16);
    const float ipos = (float)(q0 + wid * QBLK + r32), qpos = ipos - 4.f * (float)hi;
    const int tdiag = (q0 + wid * QBLK) >> 6;
    bf16x8 ka0, ka1;
    { unsigned w1, w2, w3; split3(slope2 * (float)r32, w1, w2, w3); u32x4 w; w.x = 0x3f803f80u; w.y = 0x3f80u | (w1 << 16); w.z = w2 | (w3 << 16); w.w = 0u; ka0 = __builtin_bit_cast(bf16x8, w);
      split3(slope2 * (float)(32 + r32), w1, w2, w3); w.y = 0x3f80u | (w1 << 16); w.z = w2 | (w3 << 16); ka1 = __builtin_bit_cast(bf16x8, w); }
    const int sr = tid >> 4, sc = (tid & 15) * 8, vst0 = v_st(sr, sc), vst1 = v_st(32 + sr, sc);
    const int kr = tid >> 3, kc = (tid & 7) * 8, kst = AT_KSWZ(kr, kc * 2);
    const int vb0 = (int)(uintptr_t)V_lds + v_rd_base(lane);
    struct { bf16x8 vs0, vs1, ks0; } sr_[2];
#define AT_SLOAD(i, k0) do { sr_[i].vs0 = *(const bf16x8*)(&Vh[(size_t)((k0) + sr) * LD + sc]); sr_[i].vs1 = *(const bf16x8*)(&Vh[(size_t)((k0) + 32 + sr) * LD + sc]); \
    sr_[i].ks0 = *(const bf16x8*)(&Kh[(size_t)((k0) + kr) * LD + kc]); } while (0)
#define AT_SWRITE(b, i) do { *(LAS bf16x8*)(V_lds + (b) * SHM_V + vst0) = sr_[i].vs0; *(LAS bf16x8*)(V_lds + (b) * SHM_V + vst1) = sr_[i].vs1; \
    *(LAS bf16x8*)(K_lds + (b) * SHM_K + kst) = sr_[i].ks0; } while (0)
#define AT_RESC(a, mv) do { if (mv) { if (hi == 0) al_l[r32] = (a); asm volatile("s_waitcnt lgkmcnt(0)" ::: "memory"); \
    _Pragma("unroll") for (int d = 0; d < 4; ++d) _Pragma("unroll") for (int r = 0; r < 16; ++r) o[d][r] *= al_l[crow(r, hi)]; } } while (0)
#define AT_QKT(P0, P1, b, t) do { const int t_ = (t); const float di_ = ipos - (float)(t_ * KVBLK); \
    const bf16x8 qa_ = build_qa(t_ < tdiag ? -m_reg - slope2 * di_ : (t_ > tdiag ? -m_reg + slope2 * di_ : -m_reg), t_ < tdiag ? 0x3f80u : (t_ > tdiag ? 0xbf80u : 0u), hi); \
    qkt(P0, P1, K_lds + (b) * SHM_K, qr, qa_, ka0, ka1, r32, hi); if (t_ == tdiag) add_abs_bias(P0, P1, qpos - (float)(t_ * KVBLK), -slope2); } while (0)
    f32x16 pA0, pA1, pB0, pB1; float alA, alB; bool mvA, mvB; bf16x8 pa0, pa1, pa2, pa3; const int kb0 = tlo * KVBLK;
    AT_SLOAD(0, kb0); asm volatile("s_waitcnt vmcnt(0)" ::: "memory"); AT_SWRITE(0, 0); __syncthreads();
    AT_QKT(pA0, pA1, 0, tlo); partialSM(pA0, pA1, m_reg, alA, mvA); AT_RESC(alA, mvA);
    AT_SLOAD(1, kb0 + KVBLK); AT_SLOAD(0, kb0 + 2 * KVBLK);
    AT_SWRITE(1, 1); __syncthreads();
    for (int j = 1; j + 1 < NT; j += 2) {
        AT_SBAR(); AT_QKT(pB0, pB1, 1, tlo + j);
        finishSM(pA0, pA1, alA, l_reg, pa0, pa1, pa2, pa3); AT_SBAR();
        AT_SLOAD(1, kb0 + (j + 2) * KVBLK); AT_SBAR();
        pv_d0(o, vb0, pa0, pa1, pa2, pa3); partialSM(pB0, pB1, m_reg, alB, mvB);
        __syncthreads(); AT_SWRITE(0, 0);
        AT_RESC(alB, mvB); __syncthreads();
        AT_SBAR(); AT_QKT(pA0, pA1, 0, tlo + j + 1);
        finishSM(pB0, pB1, alB, l_reg, pa0, pa1, pa2, pa3); AT_SBAR();
        if (j + 3 < NT) AT_SLOAD(0, kb0 + (j + 3) * KVBLK); AT_SBAR();
        pv_d0(o, vb0 + SHM_V, pa0, pa1, pa2, pa3); partialSM(pA0, pA1, m_reg, alA, mvA);
        __syncthreads(); AT_SWRITE(1, 1);
        AT_RESC(alA, mvA); __syncthreads();
    }
    AT_SBAR(); AT_QKT(pB0, pB1, 1, tlo + NT - 1);
    finishSM(pA0, pA1, alA, l_reg, pa0, pa1, pa2, pa3); AT_SBAR();
    pv_d0(o, vb0, pa0, pa1, pa2, pa3); partialSM(pB0, pB1, m_reg, alB, mvB);
    __syncthreads(); AT_RESC(alB, mvB);
    finishSM(pB0, pB1, alB, l_reg, pa0, pa1, pa2, pa3); AT_SBAR();
    pv_d0(o, vb0 + SHM_V, pa0, pa1, pa2, pa3);
    if (hi == 0) li_l[r32] = l_reg; asm volatile("s_waitcnt lgkmcnt(0)" ::: "memory");
    float rli[16];
#pragma unroll
    for (int r = 0; r < 16; ++r) rli[r] = __builtin_amdgcn_rcpf(li_l[crow(r, hi)]);
    bf16_t* Ow = Oh + (size_t)(q0 + wid * QBLK) * LD;
#pragma unroll
    for (int r = 0; r < 16; ++r) { const int orow = crow(r, hi);
#pragma unroll
        for (int d0 = 0; d0 < 4; ++d0) Ow[(size_t)orow * LD + d0 * 32 + r32] = (bf16_t)f2bf(o[d0][r] * rli[r]); }
    __syncthreads();
#undef AT_SLOAD
#undef AT_SWRITE
#undef AT_RESC
#undef AT_QKT
}
}

__device__ __forceinline__ void combine_pass(Frame& F, const Args& A, const bf16_t* o1, const bf16_t* o2, bf16_t* out) {
    const int gw = F.vcu * NWAVES + F.wave, NGW = F.G * NWAVES;
    const float d1 = wave_sum(A.in[I_LQ1][F.lane] * A.in[I_LK1][F.lane]), d2 = wave_sum(A.in[I_LQ2][F.lane] * A.in[I_LK2][F.lane]);
    const float lam_init = 0.8f - 0.6f * 1.0f;
    const float lam = __expf(d1) - __expf(d2) + lam_init;
    float gsub[16];
#pragma unroll
    for (int j = 0; j < 16; ++j) gsub[j] = A.in[I_SUBLN][(F.lane & 7) * 16 + j] * (1.0f - lam_init);
    for (int m = gw; m < TOK; m += NGW) {
        const u32x4* p1 = (const u32x4*)(o1 + (size_t)m * DM + F.lane * 16); const u32x4* p2 = (const u32x4*)(o2 + (size_t)m * DM + F.lane * 16);
        const u32x4 a0 = p1[0], a1 = p1[1], b0 = p2[0], b1 = p2[1];
        float v[16]; float s = 0.f;
#pragma unroll
        for (int j = 0; j < 4; ++j) {
            const unsigned ua = a0[j], ub = b0[j], uc = a1[j], ud = b1[j];
            v[2 * j]     = __builtin_bit_cast(float, ua << 16) - lam * __builtin_bit_cast(float, ub << 16);
            v[2 * j + 1] = __builtin_bit_cast(float, ua & 0xffff0000u) - lam * __builtin_bit_cast(float, ub & 0xffff0000u);
            v[8 + 2 * j]     = __builtin_bit_cast(float, uc << 16) - lam * __builtin_bit_cast(float, ud << 16);
            v[8 + 2 * j + 1] = __builtin_bit_cast(float, uc & 0xffff0000u) - lam * __builtin_bit_cast(float, ud & 0xffff0000u);
        }
#pragma unroll
        for (int j = 0; j < 16; ++j) s += v[j] * v[j];
        s += __shfl_xor(s, 1); s += __shfl_xor(s, 2); s += __shfl_xor(s, 4);
        const float rstd = 1.0f / sqrtf(s * (1.0f / 128.0f) + EPS);
        u32x4 w0, w1;
        w0.x = pk2(v[0] * rstd * gsub[0], v[1] * rstd * gsub[1]); w0.y = pk2(v[2] * rstd * gsub[2], v[3] * rstd * gsub[3]); w0.z = pk2(v[4] * rstd * gsub[4], v[5] * rstd * gsub[5]); w0.w = pk2(v[6] * rstd * gsub[6], v[7] * rstd * gsub[7]);
        w1.x = pk2(v[8] * rstd * gsub[8], v[9] * rstd * gsub[9]); w1.y = pk2(v[10] * rstd * gsub[10], v[11] * rstd * gsub[11]); w1.z = pk2(v[12] * rstd * gsub[12], v[13] * rstd * gsub[13]); w1.w = pk2(v[14] * rstd * gsub[14], v[15] * rstd * gsub[15]);
        u32x4* po = (u32x4*)(out + (size_t)m * DM + F.lane * 16); po[0] = w0; po[1] = w1;
    }
}

__device__ __forceinline__ void router_pass(Frame& F, const Args& A, int layer, const float* x, bf16_t* outb, gu32* cntw, int* list, float* rw) {
    const int gw = F.vcu * NWAVES + F.wave, NGW = F.G * NWAVES;
    const float* g = A.in[I_NFFN] + layer * DM; const float* modl = (const float*)(F.ws + WS_MISC + MS_MOD) + (size_t)layer * 2 * 6144;
    const float* rgw = A.in[I_RGW] + (size_t)layer * DM * 4; const float* rgb = A.in[I_RGB] + layer * 4;
    const float* rew = A.in[I_REW] + (size_t)layer * DM * 16; const float* reb = A.in[I_REB] + layer * 16;
    f32x4 gv[4];
#pragma unroll
    for (int j = 0; j < 4; ++j) gv[j] = *((const GAS f32x4*)g + F.lane + 64 * j);
    for (int m = gw; m < TOK; m += NGW) {
        f32x4 v[4]; ld_row(x + (size_t)m * DM, F.lane, v);
        const float rstd = row_rstd(v);
        const float* mb = modl + (size_t)(m >> 13) * 6144;
        GAS u32x2* o8 = (GAS u32x2*)(outb + (size_t)m * DM) + F.lane;
        float lg[4] = {0.f, 0.f, 0.f, 0.f};
#pragma unroll
        for (int j = 0; j < 4; ++j) { const f32x4 sh = *((const GAS f32x4*)(mb + 3072) + F.lane + 64 * j), sc = *((const GAS f32x4*)(mb + 4096) + F.lane + 64 * j);
            v[j] = v[j] * rstd * gv[j] * (sc + 1.0f) + sh; u32x2 w; w.x = pk2(v[j].x, v[j].y); w.y = pk2(v[j].z, v[j].w); o8[64 * j] = w;
            const GAS f32x4* wr = (const GAS f32x4*)rgw + (4 * F.lane + 256 * j);
#pragma unroll
            for (int e = 0; e < 4; ++e) { const f32x4 w4 = wr[e]; lg[0] += v[j][e] * w4.x; lg[1] += v[j][e] * w4.y; lg[2] += v[j][e] * w4.z; lg[3] += v[j][e] * w4.w; } }
#pragma unroll
        for (int e = 0; e < 4; ++e) lg[e] = wave_sum(lg[e]) + rgb[e];
        int gi = 0; float gm = lg[0];
#pragma unroll
        for (int e = 1; e < 4; ++e) if (lg[e] > gm) { gm = lg[e]; gi = e; }
        float gden = 0.f;
#pragma unroll
        for (int e = 0; e < 4; ++e) gden += __expf(lg[e] - gm);
        const float gprob = 1.0f / gden;
        gi = __builtin_amdgcn_readfirstlane(gi);
        float le[4] = {0.f, 0.f, 0.f, 0.f};
#pragma unroll
        for (int j = 0; j < 4; ++j) { const GAS f32x4* wr = (const GAS f32x4*)rew + (size_t)(4 * F.lane + 256 * j) * 4 + gi;
#pragma unroll
            for (int e = 0; e < 4; ++e) { const f32x4 w4 = wr[e * 4]; le[0] += v[j][e] * w4.x; le[1] += v[j][e] * w4.y; le[2] += v[j][e] * w4.z; le[3] += v[j][e] * w4.w; } }
#pragma unroll
        for (int e = 0; e < 4; ++e) le[e] = wave_sum(le[e]) + reb[gi * 4 + e];
        int i1 = 0; float v1 = le[0];
#pragma unroll
        for (int e = 1; e < 4; ++e) if (le[e] > v1) { v1 = le[e]; i1 = e; }
        int i2 = -1; float v2 = -3.0e38f;
#pragma unroll
        for (int e = 0; e < 4; ++e) if (e != i1 && le[e] > v2) { v2 = le[e]; i2 = e; }
        const float w1 = 1.0f / (1.0f + __expf(v2 - v1)), w2 = 1.0f - w1;
        const int lo = i1 < i2 ? i1 : i2, hi = i1 < i2 ? i2 : i1;
        const float wlo = (i1 < i2 ? w1 : w2) * gprob, whi = (i1 < i2 ? w2 : w1) * gprob;
        const int pid = lo == 0 ? hi - 1 : (lo == 1 ? hi + 1 : 5);
        const int bkt = gi * 6 + pid;
        if (F.lane == 0) { const unsigned pos = __hip_atomic_fetch_add(cntw + 64 * bkt, 1u, RLX_AGENT); list[bkt * 16384 + pos] = m; rw[m * 2] = wlo; rw[m * 2 + 1] = whi; }
    }
}

#define FFT_DFT4(ar, ai, br, bi, cr, ci, dr, di) do { const float s0r = ar + cr, s0i = ai + ci, d0r = ar - cr, d0i = ai - ci, s1r = br + dr, s1i = bi + di, d1r = br - dr, d1i = bi - di; \
    ar = s0r + s1r; ai = s0i + s1i; cr = s0r - s1r; ci = s0i - s1i; br = d0r + d1i; bi = d0i - d1r; dr = d0r - d1i; di = d0i + d1r; } while (0)
#define FFT_TW(xr_, xi_, c_, s_) do { const float tr_ = xr_ * (c_) + xi_ * (s_), ti_ = xi_ * (c_) - xr_ * (s_); xr_ = tr_; xi_ = ti_; } while (0)
__device__ __forceinline__ void dft16(float (&xr)[16], float (&xi)[16]) {
#pragma unroll
    for (int n2 = 0; n2 < 4; ++n2) FFT_DFT4(xr[n2], xi[n2], xr[4 + n2], xi[4 + n2], xr[8 + n2], xi[8 + n2], xr[12 + n2], xi[12 + n2]);
    FFT_TW(xr[5], xi[5], 0.92387953251128674f, 0.38268343236508977f);
    FFT_TW(xr[6], xi[6], 0.70710678118654752f, 0.70710678118654752f);
    FFT_TW(xr[7], xi[7], 0.38268343236508977f, 0.92387953251128674f);
    FFT_TW(xr[9], xi[9], 0.70710678118654752f, 0.70710678118654752f);
    { const float tr_ = xi[10], ti_ = -xr[10]; xr[10] = tr_; xi[10] = ti_; }
    FFT_TW(xr[11], xi[11], -0.70710678118654752f, 0.70710678118654752f);
    FFT_TW(xr[13], xi[13], 0.38268343236508977f, 0.92387953251128674f);
    FFT_TW(xr[14], xi[14], -0.70710678118654752f, 0.70710678118654752f);
    FFT_TW(xr[15], xi[15], -0.92387953251128674f, -0.38268343236508977f);
#pragma unroll
    for (int k1 = 0; k1 < 4; ++k1) FFT_DFT4(xr[4 * k1], xi[4 * k1], xr[4 * k1 + 1], xi[4 * k1 + 1], xr[4 * k1 + 2], xi[4 * k1 + 2], xr[4 * k1 + 3], xi[4 * k1 + 3]);
}
#define FFT_DR(k) (4 * ((k) & 3) + ((k) >> 2))
__device__ __forceinline__ void fft_phase(Frame& F, const bf16_t* zT, bf16_t* fT) {
    LAS float* Gr = (LAS float*)F.lds; LAS float* Gi = Gr + 8704; LAS float* outb = Gi + 8704;
    const float* tw = (const float*)(F.ws + WS_MISC + MS_TW);
    const int tid = F.tid;
    const int q2 = tid & 15, t1 = tid >> 4;
    const int q3 = tid & 15, v3 = (tid >> 4) & 1, p3 = tid >> 5;
    float w1r[16], w1i[16], w2r[16], w2i[16], w3r[16], w3i[16];
#pragma unroll
    for (int q = 0; q < 16; ++q) { const int i1 = tid * q, i2 = 16 * t1 * q, i3 = 256 * q;
        w1r[q] = tw[i1]; w1i[q] = tw[8192 + i1]; w2r[q] = tw[i2]; w2i[q] = tw[8192 + i2]; w3r[q] = v3 ? tw[i3] : 1.f; w3i[q] = v3 ? tw[8192 + i3] : 0.f; }
    for (int job = F.vcu; job < 2048; job += F.G) {
        const int l = job >> 1, b = job & 1;
        const bf16_t* uc = zT + (size_t)l * TOK + b * SEQ; const bf16_t* us = zT + (size_t)(1024 + l) * TOK + b * SEQ;
        float xr[16], xi[16];
#pragma unroll
        for (int k = 0; k < 16; ++k) { xr[k] = bf2f(uc[tid + 512 * k]); xi[k] = -bf2f(us[tid + 512 * k]); }
        dft16(xr, xi);
#pragma unroll
        for (int q = 0; q < 16; ++q) { float a = xr[FFT_DR(q)], c = xi[FFT_DR(q)]; FFT_TW(a, c, w1r[q], w1i[q]); Gr[tid * 17 + q] = a; Gi[tid * 17 + q] = c; }
        __syncthreads();
#pragma unroll
        for (int t2 = 0; t2 < 16; ++t2) { xr[t2] = Gr[(t1 + 32 * t2) * 17 + q2]; xi[t2] = Gi[(t1 + 32 * t2) * 17 + q2]; }
        dft16(xr, xi);
        __syncthreads();
#pragma unroll
        for (int p = 0; p < 16; ++p) { float a = xr[FFT_DR(p)], c = xi[FFT_DR(p)]; FFT_TW(a, c, w2r[p], w2i[p]); Gr[p * 512 + tid] = a; Gi[p * 512 + tid] = c; }
        __syncthreads();
#pragma unroll
        for (int u = 0; u < 16; ++u) { xr[u] = Gr[p3 * 512 + (2 * u + v3) * 16 + q3]; xi[u] = Gi[p3 * 512 + (2 * u + v3) * 16 + q3]; }
        dft16(xr, xi);
#pragma unroll
        for (int r3 = 0; r3 < 16; ++r3) { const float a = xr[FFT_DR(r3)], c = xi[FFT_DR(r3)]; const float dr = a * w3r[r3] + c * w3i[r3];
            const float pr = __shfl_xor(dr, 16); const float y = v3 ? pr - dr : dr + pr;
            outb[q3 + 16 * p3 + 256 * r3 + 4096 * v3] = y; }
        __syncthreads();
        bf16_t* o = fT + (size_t)l * TOK + b * SEQ;
#pragma unroll
        for (int it = 0; it < 2; ++it) { const int k0 = 8 * (tid + NTHREADS * it); const f32x4 r0 = *(const LAS f32x4*)(outb + k0), r1 = *(const LAS f32x4*)(outb + k0 + 4); const float sc = 0.011048543456039806f;
            u32x4 w; w.x = pk2(r0.x * sc, r0.y * sc); w.y = pk2(r0.z * sc, r0.w * sc); w.z = pk2(r1.x * sc, r1.y * sc); w.w = pk2(r1.z * sc, r1.w * sc); *(u32x4*)(o + k0) = w; }
    }
    __syncthreads();
}
__device__ __forceinline__ void transpose_phase(Frame& F, const bf16_t* fT, bf16_t* f) {
    LAS unsigned short* tile = (LAS unsigned short*)(F.lds + F.wave * 12288);
    const int gw = F.vcu * NWAVES + F.wave, NGW = F.G * NWAVES;
    for (int t = gw; t < 16 * 256; t += NGW) { const int lb = t >> 8, tb = t & 255;
#pragma unroll
        for (int it = 0; it < 8; ++it) { const int r = it * 8 + (F.lane >> 3), ch = F.lane & 7; *(LAS u32x4*)(tile + r * 72 + ch * 8) = *(const u32x4*)(fT + (size_t)(lb * 64 + r) * TOK + tb * 64 + ch * 8); }
        LDS_WAIT(); asm volatile("" ::: "memory");
#pragma unroll
        for (int it = 0; it < 8; ++it) { const int tk = it * 8 + (F.lane >> 3), c = F.lane & 7; unsigned short e[8];
#pragma unroll
            for (int q = 0; q < 8; ++q) e[q] = tile[(8 * c + q) * 72 + tk];
            u32x4 w; w.x = e[0] | ((unsigned)e[1] << 16); w.y = e[2] | ((unsigned)e[3] << 16); w.z = e[4] | ((unsigned)e[5] << 16); w.w = e[6] | ((unsigned)e[7] << 16);
            *(u32x4*)(f + (size_t)(tb * 64 + tk) * DM + lb * 64 + c * 8) = w; }
        LDS_WAIT(); asm volatile("" ::: "memory");
    }
}

#ifndef MK_N_LAUNCHES
#define MK_N_LAUNCHES 1
#endif
constexpr int N_PHASES = 18;
__global__ void __launch_bounds__(NTHREADS, 2) mk_fwd(Args args) {
    extern __shared__ __attribute__((aligned(16))) unsigned char lds_raw[];
    Frame F;
    F.lds = (LAS unsigned char*)lds_raw;
    F.tid = threadIdx.x; F.lane = F.tid & 63; F.wave = __builtin_amdgcn_readfirstlane(F.tid >> 6);
    F.G = gridDim.x; { const int bx = blockIdx.x; F.vcu = (F.G % 8 == 0) ? (bx % 8) * (F.G / 8) + bx / 8 : bx; }
    F.ws = args.ws; F.ctl = (gu32*)(args.ws + WS_CTL);
    unsigned char* ws = args.ws;
    for (int u = F.tid; u < (LDS_BYTES - LDSCTL_OFF) / 4; u += NTHREADS) ((LAS unsigned*)(F.lds + LDSCTL_OFF))[u] = 0u;
    __syncthreads();
    volatile LAS unsigned* MISC = (volatile LAS unsigned*)(F.lds + MISC_OFF);
    LAS int* mtab = (LAS int*)(F.lds + RING_BYTES + 1024);
    XcdBarrier bar = xcd_barrier_post((unsigned*)(F.ctl + CW_BAR), MISC + 8);
    const int lo = args.ph_lo, hi = args.ph_hi;
#ifndef PH_MASK
#define PH_MASK 0x3ffff
#endif
#define IN(k) (((PH_MASK >> (k)) & 1) && lo <= (k) && (k) < hi)
#define SEAM(k) do { if (IN((k) + 1)) xcd_barrier(bar); } while (0)
    float* mod = (float*)(ws + WS_MISC + MS_MOD);
    float* X = (float*)(ws + WS_X); bf16_t* H = (bf16_t*)(ws + WS_H);
    bf16_t* Qb = (bf16_t*)(ws + WS_Q); bf16_t* Kb = (bf16_t*)(ws + WS_K); bf16_t* Vb = (bf16_t*)(ws + WS_V);
    bf16_t* ON = (bf16_t*)args.out;
    int* list = (int*)(ws + WS_LIST); float* rw = (float*)(ws + WS_MISC + MS_RW);
    bf16_t* HID = (bf16_t*)(ws + WS_HID); bf16_t* ZT = (bf16_t*)(ws + WS_ZT); bf16_t* FT = (bf16_t*)(ws + WS_FT);

#define REFRESH() do { int t_ = threadIdx.x; asm volatile("" : "+v"(t_)); F.tid = t_; F.lane = t_ & 63; } while (0)
#ifndef REP0
#define REP0 1
#endif
#ifndef REP11
#define REP11 1
#endif
#ifndef REP2
#define REP2 1
#endif
#ifndef REP7
#define REP7 1
#endif
    if (IN(0)) { for (int rep = 0; rep < REP0; ++rep) { p0_prologue(F, args); __syncthreads(); } SEAM(0); }
    if (IN(1)) { REFRESH(); norm_pass(F, args.in[I_X], args.in[I_NMIX], mod, 0, 1024, H, nullptr); SEAM(1); }
    if (IN(2)) { DenseSched S; S.init(H, ws + WS_WQKV, TOK, 3072, 1024, 1024, F.G, (int)blockIdx.x);
        EpiQKV E{Qb, (size_t)TOK * DM, 0.125f * LOG2E, (unsigned*)(F.ctl + CW_NMAX)};
        for (int rep = 0; rep < REP2; ++rep) pg8::gemm_phase<EpiQKV, DenseSched, false>(F.lds, 1024, 1024, 1024, S, E); SEAM(2); }
    if (IN(3)) {
        volatile LAS int* qslot = (volatile LAS int*)(F.lds + RING_BYTES + 2048);
        gu32* qhead = F.ctl + CW_QHEAD; const gu32* nmax = F.ctl + CW_NMAX;
        int idx = 0;
        if (F.tid == 0) qslot[0] = (int)__hip_atomic_fetch_add(qhead, 1u, RLX_AGENT);
        __syncthreads(); idx = __builtin_amdgcn_readfirstlane(qslot[0]); __syncthreads();
        while (idx < 1024) {
            if (F.tid == 0) qslot[0] = (int)__hip_atomic_fetch_add(qhead, 1u, RLX_AGENT);
            const int head = 7 - (idx >> 7), rem = idx & 127, b = rem >> 6, which = (rem >> 5) & 1, qb = rem & 31, h16 = head * 2 + which;
            const size_t rb = (size_t)b * SEQ * DM; const float slope2 = exp2f(-(float)(head + 1)) * LOG2E;
            const float q2 = __uint_as_float(__hip_atomic_load(nmax + ((0 * 2 + b) * 16 + h16) * 2, RLX_AGENT)) + __uint_as_float(__hip_atomic_load(nmax + ((0 * 2 + b) * 16 + h16) * 2 + 1, RLX_AGENT));
            const float k2 = __uint_as_float(__hip_atomic_load(nmax + ((1 * 2 + b) * 16 + h16) * 2, RLX_AGENT)) + __uint_as_float(__hip_atomic_load(nmax + ((1 * 2 + b) * 16 + h16) * 2 + 1, RLX_AGENT));
            const float reach = (2.0f * 1.02f * sqrtf(q2 * k2) + 152.0f) / slope2;
            const int dcut = reach < 16384.f ? (int)reach + 1 : 16384;
            int tlo = (qb * 256 - dcut) >> 6, thi = (qb * 256 + 255 + dcut) >> 6; tlo = tlo < 0 ? 0 : tlo; thi = thi > 127 ? 127 : thi;
            if (((thi - tlo + 1) & 1) != 0) { if (thi < 127) ++thi; else --tlo; }
            tlo = __builtin_amdgcn_readfirstlane(tlo); thi = __builtin_amdgcn_readfirstlane(thi);
            attn::unit(Qb + rb + h16 * 64, Kb + rb + h16 * 64, Vb + rb + head * 128, ON + (size_t)which * TOK * DM + rb + head * 128, qb * 256, slope2, tlo, thi - tlo + 1, (LAS char*)F.lds);
            idx = __builtin_amdgcn_readfirstlane(qslot[0]); __syncthreads();
        }
        SEAM(3); }
    if (IN(4)) { REFRESH(); combine_pass(F, args, ON, ON + (size_t)TOK * DM, H); SEAM(4); }
    if (IN(5)) { DenseSched S; S.init(H, ws + WS_WO, TOK, 1024, 1024, 1024, F.G, (int)blockIdx.x);
        EpiRes E{args.in[I_X], X, mod, 2048};
        pg8::gemm_phase<EpiRes, DenseSched, false>(F.lds, 1024, 1024, 1024, S, E); SEAM(5); }
#define MOE_LAYER(layer, pb) do { \
        gu32* cntw = F.ctl + CW_CNT + (layer) * NBUCKET * 64; \
        const float* modl = mod + (size_t)(layer) * 2 * 6144; \
        if (IN(pb)) { REFRESH(); router_pass(F, args, (layer), X, H, cntw, list, rw); SEAM(pb); } \
        if (IN((pb) + 1)) { REFRESH(); moe_build_tab(F, cntw, mtab); \
            Moe1Sched S{mtab, list, (const char*)H, (const char*)(ws + WS_WGU) + (size_t)(layer) * 16 * 1024 * 1024 * 2, F.G, F.vcu}; \
            EpiSwiGLU E{HID, mtab, list, rw}; \
            for (int rep = 0; rep < REP7; ++rep) pg8::gemm_phase<EpiSwiGLU, Moe1Sched, true>(F.lds, 1024, 1024, 1024, S, E); SEAM((pb) + 1); } \
        if (IN((pb) + 2)) { REFRESH(); moe_build_tab(F, cntw, mtab); \
            Moe2Sched S{mtab, (const char*)HID, (const char*)(ws + WS_WD) + (size_t)(layer) * 4 * 1024 * 2048 * 2, F.G, F.vcu}; \
            EpiMoe2 E{X, mtab, list, modl, 5120}; \
            pg8::gemm_phase<EpiMoe2, Moe2Sched, false>(F.lds, 1024, 1024, 2048, S, E); SEAM((pb) + 2); } } while (0)
    MOE_LAYER(0, 6);
    if (IN(9)) { REFRESH(); norm_pass(F, X, args.in[I_NMIX] + DM, mod + 2 * 6144, 0, 1024, H, nullptr); SEAM(9); }
    if (IN(10)) { DenseSched S; S.init(ws + WS_WFI, H, 2048, TOK, 1024, 1024, F.G, (int)blockIdx.x);
        EpiBf16 E{ZT, TOK, 0, 0, 1.f};
        pg8::gemm_phase<EpiBf16, DenseSched, false>(F.lds, 1024, 1024, 1024, S, E); SEAM(10); }
    if (IN(11)) { REFRESH(); for (int rep = 0; rep < REP11; ++rep) fft_phase(F, ZT, FT); SEAM(11); }
    if (IN(12)) { REFRESH(); transpose_phase(F, FT, H); SEAM(12); }
    if (IN(13)) { DenseSched S; S.init(H, ws + WS_WFO, TOK, 1024, 1024, 1024, F.G, (int)blockIdx.x);
        EpiRes E{X, X, mod + 2 * 6144, 2048};
        pg8::gemm_phase<EpiRes, DenseSched, false>(F.lds, 1024, 1024, 1024, S, E); SEAM(13); }
    MOE_LAYER(1, 14);
    if (IN(17)) { REFRESH(); norm_pass(F, X, args.in[I_NFIN], nullptr, 0, 0, nullptr, args.out); }
#undef IN
#undef SEAM
}

extern "C" void kernel_launch(void* const* d_in, const int* in_sizes, int n_in, void* d_out, int out_size, void* d_ws, size_t ws_size, hipStream_t stream) {
    static int ok = 0;
    if (ok == 0) {
        if (n_in != 23 || in_sizes[0] != TOK * DM || out_size != TOK * DM || ws_size < WS_END) { fprintf(stderr, "kernel_launch: unexpected shapes (n_in %d, in0 %d, out %d, ws %zu < %zu); nothing launched\n", n_in, n_in > 0 ? in_sizes[0] : -1, out_size, ws_size, (size_t)WS_END); ok = -1; return; }
        if (hipFuncSetAttribute((const void*)mk_fwd, hipFuncAttributeMaxDynamicSharedMemorySize, LDS_BYTES) != hipSuccess) { fprintf(stderr, "kernel_launch: hipFuncSetAttribute failed\n"); ok = -1; return; }
        ok = 1;
    }
    if (ok < 0) return;
    (void)hipMemsetAsync((char*)d_ws + WS_CTL, 0, CTL_ZERO_BYTES, stream);
    Args a{};
    for (int i = 0; i < 23; ++i) a.in[i] = (const float*)d_in[i];
    a.out = (float*)d_out; a.ws = (unsigned char*)d_ws;
#if MK_N_LAUNCHES == 1
    a.ph_lo = 0; a.ph_hi = N_PHASES;
    hipLaunchKernelGGL(mk_fwd, dim3(256), dim3(NTHREADS), LDS_BYTES, stream, a);
#else
    for (int p = 0; p < N_PHASES; ++p) { a.ph_lo = p; a.ph_hi = p + 1; hipLaunchKernelGGL(mk_fwd, dim3(256), dim3(NTHREADS), LDS_BYTES, stream, a); }
#endif
}
```

```cpp
#include <hip/hip_runtime.h>
#include <cstdio>
#include <cstdint>

#define LAS __attribute__((address_space(3)))
#define GAS __attribute__((address_space(1)))
typedef unsigned short bf16_t;
typedef short bf16x8 __attribute__((ext_vector_type(8)));
typedef short s16x4 __attribute__((ext_vector_type(4)));
typedef float f32x4 __attribute__((ext_vector_type(4)));
typedef float f32x2 __attribute__((ext_vector_type(2)));
typedef float f32x16 __attribute__((ext_vector_type(16)));
typedef unsigned u32x4 __attribute__((ext_vector_type(4)));
typedef unsigned u32x2 __attribute__((ext_vector_type(2)));
typedef GAS unsigned gu32;

constexpr int NB = 2, SEQ = 8192, DM = 1024, TOK = NB * SEQ;
constexpr int NHEAD = 8, DH = 64, DV = 128;
constexpr int NEXP = 16, DEXP = 512, NBUCKET = 24;
constexpr int NWAVES = 8, NTHREADS = 512;
constexpr float EPS = 1e-6f;
constexpr float LOG2E = 1.4426950408889634f;

__device__ __forceinline__ unsigned f2bf(float f) { unsigned u = __builtin_bit_cast(unsigned, f); return (u + 0x7fffu + ((u >> 16) & 1u)) >> 16; }
__device__ __forceinline__ unsigned pk2(float lo, float hi) { return f2bf(lo) | (f2bf(hi) << 16); }
__device__ __forceinline__ float bf2f(unsigned short h) { return __builtin_bit_cast(float, (unsigned)h << 16); }
__device__ __forceinline__ unsigned cvt_pk_bf16(float lo, float hi) { unsigned r; asm volatile("v_cvt_pk_bf16_f32 %0, %1, %2" : "=v"(r) : "v"(lo), "v"(hi)); return r; }
#define WS_DPP(v, ctrl) __builtin_bit_cast(float, __builtin_amdgcn_update_dpp(0, __builtin_bit_cast(int, v), ctrl, 0xf, 0xf, false))
__device__ __forceinline__ float xor16_add(float v) { auto r = __builtin_amdgcn_permlane16_swap(__float_as_uint(v), __float_as_uint(v), false, false); return __uint_as_float(r[0]) + __uint_as_float(r[1]); }
__device__ __forceinline__ float xor32_add(float v) { auto r = __builtin_amdgcn_permlane32_swap(__float_as_uint(v), __float_as_uint(v), false, false); return __uint_as_float(r[0]) + __uint_as_float(r[1]); }
__device__ __forceinline__ float wave_sum(float v) {
    v += WS_DPP(v, 0xB1);
    v += WS_DPP(v, 0x4E);
    v += WS_DPP(v, 0x141);
    v += WS_DPP(v, 0x140);
    v = xor16_add(v);
    return xor32_add(v);
}
__device__ __forceinline__ float sum8(float v) { v += WS_DPP(v, 0xB1); v += WS_DPP(v, 0x4E); v += WS_DPP(v, 0x141); return v; }
__device__ __forceinline__ float max16(float v) { v = fmaxf(v, WS_DPP(v, 0xB1)); v = fmaxf(v, WS_DPP(v, 0x4E)); v = fmaxf(v, WS_DPP(v, 0x141)); v = fmaxf(v, WS_DPP(v, 0x140)); return v; }

namespace pg8 {
constexpr int BM = 256, BK = 64, HALF = 128, HTB = HALF * BK * 2, STAGE_BYTES = 8 * HTB, NXCD = 8;
__host__ __device__ __forceinline__ int lds_byte(int r, int c) { const int st = (r >> 4) * 2 + (c >> 5), rr = r & 15, cc = c & 31, ob = rr * 64 + cc * 2; return st * 1024 + (ob ^ (((ob >> 9) & 1) << 5)); }
__host__ __device__ __forceinline__ void stage_rc(int b, int& R, int& C) { const int st = b / 1024, sb = b % 1024, swz = sb ^ (((sb >> 9) & 1) << 5); R = (st >> 1) * 16 + swz / 64; C = (st & 1) * 32 + (swz % 64) / 2; }
__host__ __device__ __forceinline__ int perm32(int rho) { const int n = rho >> 4, i = rho & 15; return 8 * (i >> 2) + 4 * n + (i & 3); }

struct Unit { int pm, pn; const char* a; const char* b; int jt; int jb; int aux0, aux1; };

template <class Epi, class Sched, bool GATHER>
__device__ __forceinline__ void gemm_phase(LAS unsigned char* lds, const int K, const int lda, const int ldb, const Sched& S, const Epi& E) {
    int tid = threadIdx.x; asm volatile("" : "+v"(tid));
    const int wid = __builtin_amdgcn_readfirstlane(tid >> 6), lane = tid & 63, wr = wid >> 2, wc = wid & 3, fr = lane & 15, fq = lane >> 4;
    const int nt = K / BK;
    int RA[2], CA[2];
    unsigned voffB[2], vA[2][2], nvA[2][2];
#pragma unroll
    for (int i = 0; i < 2; ++i) { int R, C; stage_rc(tid * 16 + i * 8192, R, C); const int Rb = Epi::PERM ? ((R & ~31) + perm32(R & 31)) : R;
        RA[i] = R; CA[i] = C; voffB[i] = (unsigned)(Rb * ldb + C) * 2u; }
    const size_t kstep = (size_t)(BK * 2);
    const size_t hstepB = (size_t)HALF * ldb * 2;
    const unsigned ldsw = (unsigned)wid * 1024u;
    const int aoff = lds_byte(wr * 64 + fr, fq * 8), boff = lds_byte(wc * 32 + fr, fq * 8);
#define PG8_SA(b, h) (((b) * 2 + (h)) * HTB)
#define PG8_SB(b, h) ((4 + (b) * 2 + (h)) * HTB)
#define PG8_STAGE(bufoff, gbase, voff) do { _Pragma("unroll") for (int _i = 0; _i < 2; ++_i) \
        __builtin_amdgcn_global_load_lds((const unsigned*)((const char*)(gbase) + (voff)[_i]), (LAS unsigned*)(lds + (bufoff) + ldsw + _i * 8192), 16, 0, 0); } while (0)
#define PG8_LDA(dst, b, h) do { _Pragma("unroll") for (int m = 0; m < 4; ++m) _Pragma("unroll") for (int k = 0; k < 2; ++k) dst[m][k] = *(const LAS bf16x8*)(lds + PG8_SA(b, h) + aoff + m * 2048 + k * 1024); } while (0)
#define PG8_LDB(dst, b, h) do { _Pragma("unroll") for (int n = 0; n < 2; ++n) _Pragma("unroll") for (int k = 0; k < 2; ++k) dst[n][k] = *(const LAS bf16x8*)(lds + PG8_SB(b, h) + boff + n * 2048 + k * 1024); } while (0)
#define PG8_MMA(ai, bj, At, Bt) do { __builtin_amdgcn_s_setprio(1); _Pragma("unroll") for (int m = 0; m < 4; ++m) _Pragma("unroll") for (int n = 0; n < 2; ++n) _Pragma("unroll") for (int k = 0; k < 2; ++k) \
        acc[ai][bj][m][n] = __builtin_amdgcn_mfma_f32_16x16x32_bf16(Bt[n][k], At[m][k], acc[ai][bj][m][n], 0, 0, 0); __builtin_amdgcn_s_setprio(0); } while (0)
#define PG8_WAIT_V(n) asm volatile("s_waitcnt vmcnt(" #n ")" ::: "memory")
#define PG8_WAIT_L(n) asm volatile("s_waitcnt lgkmcnt(" #n ")" ::: "memory")
#define PG8_BAR __builtin_amdgcn_s_barrier()
#define PG8_SCHED __builtin_amdgcn_sched_barrier(0)
#define PG8_SETVA(dst, u) do { _Pragma("unroll") for (int _h = 0; _h < 2; ++_h) _Pragma("unroll") for (int _i = 0; _i < 2; ++_i) { \
        if constexpr (GATHER) dst[_h][_i] = (unsigned)(S.arow(u, _h * HALF + RA[_i]) * (unsigned)lda + (unsigned)CA[_i]) * 2u; \
        else dst[_h][_i] = (unsigned)((_h * HALF + RA[_i]) * lda + CA[_i]) * 2u; } } while (0)
    Unit cur, nxt; int ui = 0;
    if (!S.next(0, cur)) return;
    PG8_SETVA(vA, cur);
#pragma unroll
    for (int h = 0; h < 2; ++h)
#pragma unroll
        for (int i = 0; i < 2; ++i) nvA[h][i] = vA[h][i];
    f32x4 acc[2][2][4][2];
#pragma unroll
    for (int a = 0; a < 2; ++a)
#pragma unroll
        for (int b = 0; b < 2; ++b)
#pragma unroll
            for (int m = 0; m < 4; ++m)
#pragma unroll
                for (int n = 0; n < 2; ++n) acc[a][b][m][n] = (f32x4){0.f, 0.f, 0.f, 0.f};
    bf16x8 At[4][2], B0[2][2], B1[2][2];
    const char* cA = cur.a; const char* cB = cur.b;
    PG8_STAGE(PG8_SB(0, 0), cB, voffB); PG8_STAGE(PG8_SB(0, 1), cB + hstepB, voffB); PG8_STAGE(PG8_SA(0, 0), cA, vA[0]); PG8_STAGE(PG8_SA(0, 1), cA, vA[1]);
    if (wr == 1) PG8_BAR;
    PG8_WAIT_V(2); PG8_BAR;
    PG8_STAGE(PG8_SB(1, 0), cB + kstep, voffB); PG8_STAGE(PG8_SA(1, 0), cA + kstep, vA[0]); PG8_STAGE(PG8_SB(1, 1), cB + hstepB + kstep, voffB);
    PG8_WAIT_V(6); PG8_BAR;
    for (;;) {
        const bool has_next = S.next(ui + 1, nxt);
        const char* nA = has_next ? nxt.a : cA; const char* nB = has_next ? nxt.b : cB;
        if constexpr (GATHER) { if (has_next) PG8_SETVA(nvA, nxt); }
        const int jt = cur.jt; const long jb = (long)cur.jb;
        for (int t = 0; t < nt; t += 2) {
            const bool last = (t == nt - 2);
            const char* a1 = cA + (size_t)(t + 1) * kstep;
            const char* a2 = last ? nA : cA + (size_t)(t + 2) * kstep;
            const char* b2 = last ? nB : cB + (size_t)(t + 2) * kstep + ((t + 2) >= jt ? jb : 0l);
            const char* a3 = a2 + kstep;
            const char* b3 = last ? nB + kstep : cB + (size_t)(t + 3) * kstep + ((t + 3) >= jt ? jb : 0l);
            unsigned w0[2], w1[2];
            if constexpr (GATHER) { w0[0] = last ? nvA[0][0] : vA[0][0]; w0[1] = last ? nvA[0][1] : vA[0][1]; w1[0] = last ? nvA[1][0] : vA[1][0]; w1[1] = last ? nvA[1][1] : vA[1][1]; }
            else { w0[0] = vA[0][0]; w0[1] = vA[0][1]; w1[0] = vA[1][0]; w1[1] = vA[1][1]; }
            PG8_LDB(B0, 0, 0); PG8_LDB(B1, 0, 1); PG8_SCHED; PG8_LDA(At, 0, 0); PG8_STAGE(PG8_SA(1, 1), a1, vA[1]);
            PG8_WAIT_V(8); PG8_WAIT_L(0); PG8_BAR; PG8_MMA(0, 0, At, B0); PG8_MMA(0, 1, At, B1); PG8_BAR; PG8_SCHED;
            PG8_LDA(At, 0, 1); PG8_STAGE(PG8_SB(0, 0), b2, voffB); PG8_STAGE(PG8_SB(0, 1), b2 + hstepB, voffB); PG8_STAGE(PG8_SA(0, 0), a2, w0);
            PG8_WAIT_V(8); PG8_WAIT_L(0); PG8_BAR; PG8_MMA(1, 0, At, B0); PG8_MMA(1, 1, At, B1); PG8_BAR; PG8_SCHED;
            PG8_LDB(B0, 1, 0); PG8_LDB(B1, 1, 1); PG8_SCHED; PG8_LDA(At, 1, 0); PG8_STAGE(PG8_SA(0, 1), a2, w1);
            PG8_WAIT_V(8); PG8_WAIT_L(0); PG8_BAR; PG8_MMA(0, 0, At, B0); PG8_MMA(0, 1, At, B1); PG8_BAR; PG8_SCHED;
            PG8_LDA(At, 1, 1); PG8_STAGE(PG8_SB(1, 0), b3, voffB); PG8_STAGE(PG8_SB(1, 1), b3 + hstepB, voffB); PG8_STAGE(PG8_SA(1, 0), a3, w0);
            PG8_WAIT_V(8); PG8_WAIT_L(0); PG8_BAR; PG8_MMA(1, 0, At, B0); PG8_MMA(1, 1, At, B1); PG8_BAR; PG8_SCHED;
        }
        if (wr == 0) PG8_BAR;
        E(acc, cur, wr, wc, fr, fq);
        if (!has_next) break;
#pragma unroll
        for (int a = 0; a < 2; ++a)
#pragma unroll
            for (int b = 0; b < 2; ++b)
#pragma unroll
                for (int m = 0; m < 4; ++m)
#pragma unroll
                    for (int n = 0; n < 2; ++n) acc[a][b][m][n] = (f32x4){0.f, 0.f, 0.f, 0.f};
        cur = nxt; cA = nA; cB = nB; ++ui;
        if constexpr (GATHER) {
#pragma unroll
            for (int h = 0; h < 2; ++h)
#pragma unroll
                for (int i = 0; i < 2; ++i) vA[h][i] = nvA[h][i];
        }
        if (wr == 1) PG8_BAR;
    }
    PG8_WAIT_V(0);
    PG8_BAR;
#undef PG8_SA
#undef PG8_SB
#undef PG8_STAGE
#undef PG8_LDA
#undef PG8_LDB
#undef PG8_MMA
#undef PG8_WAIT_V
#undef PG8_WAIT_L
#undef PG8_BAR
#undef PG8_SCHED
#undef PG8_SETVA
}
}

constexpr size_t MiB = 1u << 20;
constexpr size_t WS_CTL = 0, CTL_ZERO_BYTES = 1 * MiB;
constexpr size_t WS_MISC = 1 * MiB;
constexpr size_t WS_WQKV = 4 * MiB;
constexpr size_t WS_WO   = 10 * MiB;
constexpr size_t WS_WFI  = 12 * MiB;
constexpr size_t WS_WFO  = 16 * MiB;
constexpr size_t WS_WGU  = 18 * MiB;
constexpr size_t WS_WD   = 82 * MiB;
constexpr size_t WS_X    = 114 * MiB;
constexpr size_t WS_H    = 178 * MiB;
constexpr size_t WS_R    = 210 * MiB;
constexpr size_t WS_Q = WS_R, WS_K = WS_R + 32 * MiB, WS_V = WS_R + 64 * MiB;
constexpr size_t WS_HID = WS_R;
constexpr size_t WS_ZT = WS_R;
constexpr size_t WS_FT = WS_R + 64 * MiB;
constexpr size_t WS_AUG = 306 * MiB;
constexpr size_t WS_END = 307 * MiB;
constexpr size_t MS_MOD = 0;
constexpr size_t MS_TW  = 128 * 1024;
constexpr size_t MS_RW  = 256 * 1024;
constexpr size_t WS_LIST = 2 * MiB;
constexpr int CW_TMO = 0;
constexpr int CW_CNT = 64;
constexpr int CW_NMAX = 4096;
constexpr int CW_QHEAD = 4608;
constexpr int CW_BAR = 8192;

constexpr int RING_BYTES = 131072;
constexpr int LDSCTL_OFF = RING_BYTES, MISC_OFF = LDSCTL_OFF + 320;
constexpr int LDS_BYTES = 147456;

#define RLX_AGENT __ATOMIC_RELAXED, __HIP_MEMORY_SCOPE_AGENT
#define LDS_WAIT() asm volatile("s_waitcnt lgkmcnt(0)" ::: "memory")
#define VM_WAIT() asm volatile("s_waitcnt vmcnt(0)" ::: "memory")

#define XB_TMO      128
#define XB_XCNT(j)  (256  + 64 * (j))
#define XB_XSUB(j)  (1280 + 64 * (j))
#define XB_XGEN(j)  (2304 + 64 * (j))
#define XB_TOP      3328
#define XB_TOPGEN   3392
#define XCD_BAR_WORDS 3456
#define XB_SPIN_CAP (1u << 22)
__device__ __forceinline__ unsigned xb_ld(unsigned* p)              { return __hip_atomic_load(p, __ATOMIC_RELAXED, __HIP_MEMORY_SCOPE_AGENT); }
__device__ __forceinline__ unsigned xb_add(unsigned* p, unsigned v) { return __hip_atomic_fetch_add(p, v, __ATOMIC_RELAXED, __HIP_MEMORY_SCOPE_AGENT); }
__device__ __forceinline__ unsigned xb_xcc_id() { return (unsigned)__builtin_amdgcn_s_getreg((3 << 11) | 20) & 0xFu; }
#define XB_SPIN(cond, bar) do { unsigned _sp = 0; while (cond) { __builtin_amdgcn_s_sleep(1); \
    if ((++_sp & 255u) == 0u) { if (xb_ld(&(bar)[XB_TMO])) break; if (_sp > XB_SPIN_CAP) { atomicAdd(&(bar)[XB_TMO], 1u); break; } } } } while (0)
struct XcdBarrier { unsigned* bar; unsigned x; volatile LAS unsigned* st; };
__device__ __forceinline__ XcdBarrier xcd_barrier_post(unsigned* bar, volatile LAS unsigned* st) {
    XcdBarrier b; b.bar = bar; b.x = xb_xcc_id(); b.st = st;
    if (threadIdx.x == 0) (void)xb_add(&bar[XB_XCNT(b.x)], 1u);
    return b;
}
__device__ __forceinline__ void xcd_barrier_complete(unsigned* bar, unsigned x, unsigned& nloc, unsigned& nx) {
    const unsigned G = gridDim.x * gridDim.y * gridDim.z;
    unsigned sum, cnt, mine, sp = 0u;
    for (;;) {
        sum = 0u; cnt = 0u; mine = 0u;
#pragma unroll
        for (unsigned j = 0; j < 16; ++j) { const unsigned c = xb_ld(&bar[XB_XCNT(j)]); sum += c; cnt += (c > 0u) ? 1u : 0u; mine = (j == x) ? c : mine; }
        if (sum == G) break;
        __builtin_amdgcn_s_sleep(1);
        if ((++sp & 255u) == 0u) { if (xb_ld(&bar[XB_TMO])) break; if (sp > XB_SPIN_CAP) { atomicAdd(&bar[XB_TMO], 1u); break; } }
    }
    nloc = mine > 0u ? mine : 1u; nx = cnt > 0u ? cnt : 1u;
}
__device__ __forceinline__ void xcd_barrier(const XcdBarrier& b) {
    asm volatile("s_waitcnt vmcnt(0)" ::: "memory");
    __syncthreads();
    if (threadIdx.x == 0) {
        unsigned* bar = b.bar;
        __builtin_amdgcn_s_waitcnt(0);
        unsigned nloc = b.st[0], nx = b.st[1];
        if (nloc == 0u) { xcd_barrier_complete(bar, b.x, nloc, nx); b.st[0] = nloc; b.st[1] = nx; }
        const unsigned old = xb_add(&bar[XB_XSUB(b.x)], 1u);
        const unsigned gen = old / nloc;
        if (old + 1u == (gen + 1u) * nloc) {
            __builtin_amdgcn_fence(__ATOMIC_RELEASE, "agent");
            asm volatile("s_waitcnt vmcnt(0)" ::: "memory");
            const unsigned og = xb_add(&bar[XB_TOP], 1u);
            const unsigned tg = og / nx;
            if (og + 1u == (tg + 1u) * nx) xb_add(&bar[XB_TOPGEN], 1u);
            else XB_SPIN(xb_ld(&bar[XB_TOPGEN]) == tg, bar);
            __builtin_amdgcn_fence(__ATOMIC_ACQUIRE, "agent");
            xb_add(&bar[XB_XGEN(b.x)], 1u);
            asm volatile("s_waitcnt vmcnt(0)" ::: "memory");
        } else {
            XB_SPIN(xb_ld(&bar[XB_XGEN(b.x)]) == gen, bar);
            __builtin_amdgcn_fence(__ATOMIC_ACQUIRE, "agent");
            asm volatile("s_waitcnt vmcnt(0)" ::: "memory");
        }
    }
    __syncthreads();
}

struct Args {
    const float* in[23];
    float* out; unsigned char* ws;
    int ph_lo, ph_hi;
};
enum InIdx { I_X = 0, I_C, I_ADAW, I_ADAB, I_NMIX, I_NFFN, I_AWIN, I_LQ1, I_LK1, I_LQ2, I_LK2, I_SUBLN, I_AWOUT, I_FWIN, I_FWOUT, I_RGW, I_RGB, I_REW, I_REB, I_EWG, I_EWU, I_EWD, I_NFIN };

struct Frame {
    LAS unsigned char* lds;
    gu32* ctl;
    int tid, lane, wave, vcu, G;
    unsigned char* ws;
};

__device__ __forceinline__ void tr_item(const float* W, int ldw, int k0, int n0, bf16_t* WT, int ldt, int r0, int c0, LAS float* scr, int lane) {
    { f32x4 t[8];
#pragma unroll
      for (int i = 0; i < 8; ++i) t[i] = *(const f32x4*)(W + (size_t)(k0 + 8 * i + (lane >> 3)) * ldw + n0 + 4 * (lane & 7));
#pragma unroll
      for (int i = 0; i < 8; ++i) { LAS float* d = scr + (8 * i + (lane >> 3)) * 33 + 4 * (lane & 7); d[0] = t[i].x; d[1] = t[i].y; d[2] = t[i].z; d[3] = t[i].w; } }
    LDS_WAIT(); asm volatile("" ::: "memory");
    const int c = lane & 7;
#pragma unroll
    for (int j = 0; j < 4; ++j) { const int n = (lane >> 3) + 8 * j; const LAS float* s = scr + (8 * c) * 33 + n;
        u32x4 o; o.x = pk2(s[0 * 33], s[1 * 33]); o.y = pk2(s[2 * 33], s[3 * 33]); o.z = pk2(s[4 * 33], s[5 * 33]); o.w = pk2(s[6 * 33], s[7 * 33]);
        *(GAS u32x4*)(WT + (size_t)(r0 + n) * ldt + c0 + 8 * c) = o; }
    LDS_WAIT(); asm volatile("" ::: "memory");
}
__device__ __forceinline__ void fold_item(const float* win, bf16_t* WT, int item, LAS float* scr, const LAS float* tab, int lane) {
    const int nb = item >> 5, kb = item & 31, n0 = nb * 32, k0 = kb * 32;
    const int part = n0 >> 10, g = (n0 >> 8) & 3, l0 = n0 & 255;
    const LAS float* tb = tab + part * 256;
    LAS float* wt = scr; LAS float* tt = scr + 1152;
    const int kq = lane >> 3, lq = lane & 7;
    f32x4 acc[4];
#pragma unroll
    for (int i = 0; i < 4; ++i) acc[i] = (f32x4){0.f, 0.f, 0.f, 0.f};
    for (int c0 = 0; c0 < 256; c0 += 32) {
#pragma unroll 4
        for (int i = 0; i < 16; ++i) { const int kk = 2 * i + (lane >> 5), cc = lane & 31; wt[cc * 36 + kk] = win[(size_t)(k0 + kk) * 1024 + g * 256 + c0 + cc]; }
#pragma unroll 4
        for (int i = 0; i < 16; ++i) { const int cc = 2 * i + (lane >> 5), l = lane & 31; tt[cc * 36 + l] = tb[((l0 + l) * (c0 + cc)) & 255]; }
        LDS_WAIT(); asm volatile("" ::: "memory");
#pragma unroll 8
        for (int cc = 0; cc < 32; ++cc) { const f32x4 w = *(const LAS f32x4*)(wt + cc * 36 + 4 * kq); const f32x4 t = *(const LAS f32x4*)(tt + cc * 36 + 4 * lq);
            acc[0] += t * w.x; acc[1] += t * w.y; acc[2] += t * w.z; acc[3] += t * w.w; }
        LDS_WAIT(); asm volatile("" ::: "memory");
    }
#pragma unroll
    for (int i = 0; i < 4; ++i)
#pragma unroll
        for (int j = 0; j < 4; ++j) wt[(4 * lq + j) * 36 + 4 * kq + i] = acc[i][j] * 0.0625f;
    LDS_WAIT(); asm volatile("" ::: "memory");
    { const int n = lane >> 1, kh = (lane & 1) * 16; const LAS float* s = wt + n * 36 + kh;
      u32x4 o0, o1; o0.x = pk2(s[0], s[1]); o0.y = pk2(s[2], s[3]); o0.z = pk2(s[4], s[5]); o0.w = pk2(s[6], s[7]); o1.x = pk2(s[8], s[9]); o1.y = pk2(s[10], s[11]); o1.z = pk2(s[12], s[13]); o1.w = pk2(s[14], s[15]);
      GAS u32x4* d = (GAS u32x4*)(WT + (size_t)(n0 + n) * 1024 + k0 + kh); d[0] = o0; d[1] = o1; }
    LDS_WAIT(); asm volatile("" ::: "memory");
}

__device__ __forceinline__ void p0_prologue(Frame& F, const Args& A) {
    unsigned char* ws = F.ws;
    float* mod = (float*)(ws + WS_MISC + MS_MOD);
    LAS float* silu_c = (LAS float*)(F.lds + 112 * 1024);
    LAS float* tab = (LAS float*)(F.lds + 120 * 1024);
    LAS float* part = (LAS float*)(F.lds + 124 * 1024);
    { const int gid = blockIdx.x * NTHREADS + F.tid; if (gid < 8192) { float sv, cv; sincospif((float)gid * (1.0f / 4096.0f), &sv, &cv); float* tw = (float*)(ws + WS_MISC + MS_TW); tw[gid] = cv; tw[8192 + gid] = sv; } }
    { const int gid = blockIdx.x * NTHREADS + F.tid; if (gid < 65536) { const int head = gid >> 13, pos = gid & 8191; const float t = exp2f(-(float)(head + 1)) * LOG2E * (float)pos;
        const unsigned t1 = f2bf(t); const float r1 = t - __builtin_bit_cast(float, t1 << 16); const unsigned t2 = f2bf(r1); const float r2 = r1 - __builtin_bit_cast(float, t2 << 16); const unsigned t3 = f2bf(r2);
        u32x4 w; w.x = 0x3f803f80u; w.y = 0x3f80u | (t1 << 16); w.z = t2 | (t3 << 16); w.w = 0u; ((u32x4*)(ws + WS_AUG))[gid] = w; } }
    if (F.tid < 256) { float sv, cv; sincospif((float)F.tid * (1.0f / 128.0f), &sv, &cv); tab[F.tid] = cv; tab[256 + F.tid] = sv; }
    for (int i = F.tid; i < 2048; i += NTHREADS) { const float v = A.in[I_C][i]; silu_c[i] = v / (1.f + __expf(-v)); }
    __syncthreads();
    for (int item = blockIdx.x; item < 192; item += F.G) {
        const int l = item / 96, cb = item % 96;
        const float* W = A.in[I_ADAW] + (size_t)l * 1024 * 6144 + cb * 64;
        const int cg = F.lane & 15, rs = F.lane >> 4;
        f32x4 a0 = (f32x4){0.f, 0.f, 0.f, 0.f}, a1 = a0;
#pragma unroll 8
        for (int i = 0; i < 32; ++i) { const int row = F.wave * 128 + i * 4 + rs; const f32x4 w = *(const f32x4*)(W + (size_t)row * 6144 + cg * 4); a0 += w * silu_c[row]; a1 += w * silu_c[1024 + row]; }
#pragma unroll
        for (int j = 0; j < 4; ++j) { a0[j] = xor32_add(xor16_add(a0[j])); a1[j] = xor32_add(xor16_add(a1[j])); }
        if (rs == 0) { *(LAS f32x4*)(part + (F.wave * 2 + 0) * 64 + cg * 4) = a0; *(LAS f32x4*)(part + (F.wave * 2 + 1) * 64 + cg * 4) = a1; }
        __syncthreads();
        if (F.tid < 128) { const int b = F.tid >> 6, col = F.tid & 63; float s = 0.f;
#pragma unroll
            for (int w = 0; w < 8; ++w) s += part[(w * 2 + b) * 64 + col];
            mod[(size_t)(l * 2 + b) * 6144 + cb * 64 + col] = s + A.in[I_ADAB][l * 6144 + cb * 64 + col]; }
        __syncthreads();
    }
    LAS float* scr = (LAS float*)(F.lds + F.wave * 12288);
    const int gw = F.vcu * NWAVES + F.wave, NGW = F.G * NWAVES;
    constexpr int I_QKV = 16 * 96, I_SQ = 16 * 32, I_GU = 2 * 16 * 2 * 256, I_DN = 2 * 16 * 256, I_FOLD = 64 * 32;
    constexpr int NITEMS = I_QKV + 2 * I_SQ + I_GU + I_DN + I_FOLD;
    for (int it = gw; it < NITEMS; it += NGW) {
        int r = it;
        if (r < I_FOLD) { fold_item(A.in[I_FWIN], (bf16_t*)(ws + WS_WFI), r, scr, tab, F.lane); continue; } r -= I_FOLD;
        if (r < I_QKV) { const int kb = r / 96, nb = r % 96; tr_item(A.in[I_AWIN], 3072, kb * 64, nb * 32, (bf16_t*)(ws + WS_WQKV), 1024, nb * 32, kb * 64, scr, F.lane); continue; } r -= I_QKV;
        if (r < I_SQ) { const int kb = r / 32, nb = r % 32; tr_item(A.in[I_AWOUT], 1024, kb * 64, nb * 32, (bf16_t*)(ws + WS_WO), 1024, nb * 32, kb * 64, scr, F.lane); continue; } r -= I_SQ;
        if (r < I_SQ) { const int kb = r / 32, nb = r % 32; tr_item(A.in[I_FWOUT], 1024, kb * 64, nb * 32, (bf16_t*)(ws + WS_WFO), 1024, nb * 32, kb * 64, scr, F.lane); continue; } r -= I_SQ;
        if (r < I_GU) { const int le = r >> 9, gu = (r >> 8) & 1, kb = (r >> 4) & 15, nb = r & 15, n0 = nb * 32;
            const float* src = (gu ? A.in[I_EWU] : A.in[I_EWG]) + (size_t)le * 1024 * 512;
            tr_item(src, 512, kb * 64, n0, (bf16_t*)(ws + WS_WGU) + (size_t)le * 1024 * 1024, 1024, (n0 >> 7) * 256 + gu * 128 + (n0 & 127), kb * 64, scr, F.lane); continue; } r -= I_GU;
        { const int le = r >> 8, kb = (r >> 5) & 7, nb = r & 31, lg = le >> 2, el = le & 3;
            const float* src = A.in[I_EWD] + (size_t)le * 512 * 1024;
            tr_item(src, 1024, kb * 64, nb * 32, (bf16_t*)(ws + WS_WD) + (size_t)lg * 1024 * 2048, 2048, nb * 32, el * 512 + kb * 64, scr, F.lane); }
    }
}

__device__ __forceinline__ void ld_row(const float* row, int lane, f32x4 (&v)[4]) {
    const GAS f32x4* xr = (const GAS f32x4*)row + lane;
#pragma unroll
    for (int j = 0; j < 4; ++j) v[j] = xr[64 * j];
}
__device__ __forceinline__ float row_rstd(const f32x4 (&v)[4]) {
    float s = 0.f;
#pragma unroll
    for (int j = 0; j < 4; ++j) s += (v[j].x * v[j].x + v[j].y * v[j].y) + (v[j].z * v[j].z + v[j].w * v[j].w);
    return 1.0f / sqrtf(wave_sum(s) * (1.0f / DM) + EPS);
}
__device__ __forceinline__ void norm_pass(Frame& F, const float* x, const float* g, const float* modl  , int sh_off, int sc_off, bf16_t* outb, float* outf) {
    const int gw = F.vcu * NWAVES + F.wave, NGW = F.G * NWAVES;
    f32x4 gv[4];
#pragma unroll
    for (int j = 0; j < 4; ++j) gv[j] = *((const GAS f32x4*)g + F.lane + 64 * j);
    for (int m = gw; m < TOK; m += NGW) {
        f32x4 v[4]; ld_row(x + (size_t)m * DM, F.lane, v);
        const float rstd = row_rstd(v);
        if (outb) {
            const float* mb = modl + (size_t)(m >> 13) * 6144;
            GAS u32x2* o8 = (GAS u32x2*)(outb + (size_t)m * DM) + F.lane;
#pragma unroll
            for (int j = 0; j < 4; ++j) { const f32x4 sh = *((const GAS f32x4*)(mb + sh_off) + F.lane + 64 * j), sc = *((const GAS f32x4*)(mb + sc_off) + F.lane + 64 * j);
                const f32x4 h = v[j] * rstd * gv[j] * (sc + 1.0f) + sh; u32x2 w; w.x = pk2(h.x, h.y); w.y = pk2(h.z, h.w); o8[64 * j] = w; }
        } else {
            GAS f32x4* o = (GAS f32x4*)(outf + (size_t)m * DM) + F.lane;
#pragma unroll
            for (int j = 0; j < 4; ++j) o[64 * j] = v[j] * rstd * gv[j];
        }
    }
}

struct DenseSched {
    int nM, nN, nwg, G, c; const char* A; const char* B; size_t tA, tB;
    __device__ void init(const void* A_, const void* B_, int M, int N, int lda, int ldb, int G_, int c_) { nM = M / 256; nN = N / 256; nwg = nM * nN; G = G_; c = c_; A = (const char*)A_; B = (const char*)B_; tA = (size_t)256 * lda * 2; tB = (size_t)256 * ldb * 2; }
    __device__ __forceinline__ bool next(int i, pg8::Unit& u) const {
        const long L = (long)i * G + c; if (L >= nwg) return false;
        int wgid = (int)L; { const int q = nwg / 8, r = nwg % 8, xcd = wgid % 8, off = wgid / 8; wgid = (xcd < r ? xcd * (q + 1) : r * (q + 1) + (xcd - r) * q) + off; }
        const int nig = 8 * nN, gid = wgid / nig, fm = gid * 8, gsz = (nM - fm) < 8 ? (nM - fm) : 8;
        u.pm = fm + ((wgid % nig) % gsz); u.pn = (wgid % nig) / gsz;
        u.a = A + (size_t)u.pm * tA; u.b = B + (size_t)u.pn * tB; u.jt = 1 << 30; u.jb = 0; u.aux0 = 0; u.aux1 = 0; return true;
    }
    __device__ __forceinline__ unsigned arow(const pg8::Unit&, int) const { return 0u; }
};
struct EpiBf16 {
    static constexpr bool PERM = true;
    bf16_t* O; int ldc; int split_cols; size_t split_stride; float scale0;
    __device__ __forceinline__ void operator()(const f32x4 (&acc)[2][2][4][2], const pg8::Unit& u, int wr, int wc, int fr, int fq) const {
        const int row0 = u.pm * 256 + wr * 64 + fr; int colt = u.pn * 256; bf16_t* base = O;
        float sc = 1.f; if (split_cols) { const int t = colt / split_cols; base += (size_t)t * split_stride; colt -= t * split_cols; if (t == 0) sc = scale0; }
        const int col0 = colt + wc * 32 + 8 * fq;
#pragma unroll
        for (int ai = 0; ai < 2; ++ai)
#pragma unroll
            for (int m = 0; m < 4; ++m) { bf16_t* rowp = base + (size_t)(row0 + ai * 128 + m * 16) * ldc + col0;
#pragma unroll
                for (int bj = 0; bj < 2; ++bj) { const f32x4 v0 = acc[ai][bj][m][0] * sc, v1 = acc[ai][bj][m][1] * sc;
                    u32x4 w; w.x = cvt_pk_bf16(v0[0], v0[1]); w.y = cvt_pk_bf16(v0[2], v0[3]); w.z = cvt_pk_bf16(v1[0], v1[1]); w.w = cvt_pk_bf16(v1[2], v1[3]);
                    *(u32x4*)(rowp + bj * 128) = w; } }
    }
};
struct EpiQKV {
    static constexpr bool PERM = true;
    bf16_t* O; size_t split_stride; float scale0; unsigned* nmax;
    __device__ __forceinline__ void operator()(const f32x4 (&acc)[2][2][4][2], const pg8::Unit& u, int wr, int wc, int fr, int fq) const {
        const int t = u.pn >> 2, colt = (u.pn & 3) * 256; bf16_t* base = O + (size_t)t * split_stride; const float sc = t == 0 ? scale0 : 1.f;
        const int row0 = u.pm * 256 + wr * 64 + fr, col0 = colt + wc * 32 + 8 * fq;
        float mx[2] = {0.f, 0.f};
#pragma unroll
        for (int ai = 0; ai < 2; ++ai)
#pragma unroll
            for (int m = 0; m < 4; ++m) { bf16_t* rowp = base + (size_t)(row0 + ai * 128 + m * 16) * 1024 + col0;
#pragma unroll
                for (int bj = 0; bj < 2; ++bj) { const f32x4 v0 = acc[ai][bj][m][0] * sc, v1 = acc[ai][bj][m][1] * sc;
                    u32x4 w; w.x = cvt_pk_bf16(v0[0], v0[1]); w.y = cvt_pk_bf16(v0[2], v0[3]); w.z = cvt_pk_bf16(v1[0], v1[1]); w.w = cvt_pk_bf16(v1[2], v1[3]);
                    *(u32x4*)(rowp + bj * 128) = w;
                    if (t < 2) { float ss = (v0[0] * v0[0] + v0[1] * v0[1]) + (v0[2] * v0[2] + v0[3] * v0[3]) + (v1[0] * v1[0] + v1[1] * v1[1]) + (v1[2] * v1[2] + v1[3] * v1[3]);
                        ss = xor32_add(xor16_add(ss)); mx[bj] = fmaxf(mx[bj], ss); } } }
        if (t < 2) {
#pragma unroll
            for (int bj = 0; bj < 2; ++bj) { const float v = max16(mx[bj]);
                if ((threadIdx.x & 63) == 0) { const int b = (u.pm * 256) >> 13, map = (u.pn & 3) * 4 + bj * 2 + (wc >> 1);
                    atomicMax(nmax + ((t * 2 + b) * 16 + map) * 2 + (wc & 1), __float_as_uint(v)); } }
        }
    }
};
struct EpiRes {
    static constexpr bool PERM = false;
    const float* xin; float* xout; const float* gate  ; int g_off;
    __device__ __forceinline__ void operator()(const f32x4 (&acc)[2][2][4][2], const pg8::Unit& u, int wr, int wc, int fr, int fq) const {
        const int row0 = u.pm * 256 + wr * 64 + fr, col0 = u.pn * 256 + wc * 32 + 4 * fq;
        const float* gb = gate + (size_t)((u.pm * 256) >> 13) * 6144 + g_off + col0;
        f32x4 gv[2][2];
#pragma unroll
        for (int bj = 0; bj < 2; ++bj)
#pragma unroll
            for (int n = 0; n < 2; ++n) gv[bj][n] = *(const f32x4*)(gb + bj * 128 + n * 16);
#pragma unroll
        for (int ai = 0; ai < 2; ++ai)
#pragma unroll
            for (int m = 0; m < 4; ++m) { const size_t off = (size_t)(row0 + ai * 128 + m * 16) * DM + col0;
#pragma unroll
                for (int bj = 0; bj < 2; ++bj)
#pragma unroll
                    for (int n = 0; n < 2; ++n) { const f32x4 xi = *(const f32x4*)(xin + off + bj * 128 + n * 16); *(f32x4*)(xout + off + bj * 128 + n * 16) = xi + gv[bj][n] * acc[ai][bj][m][n]; } }
    }
};

struct MoeTab { const LAS int* cnt; const LAS int* mts; };
__device__ __forceinline__ void pair_of(int pid, int& lo, int& hi) { lo = pid < 3 ? 0 : (pid < 5 ? 1 : 2); hi = pid < 3 ? pid + 1 : (pid < 5 ? pid - 1 : 3); }
__device__ __forceinline__ void moe_build_tab(Frame& F, const gu32* cntw, LAS int* tab) {
    __syncthreads();
    if (F.tid == 0) { int s = 0;
        for (int b = 0; b < NBUCKET; ++b) { const int c = (int)__hip_atomic_load(cntw + 64 * b, RLX_AGENT); tab[b] = c; tab[32 + b] = s; s += (c + 255) >> 8; }
        tab[32 + NBUCKET] = s; }
    __syncthreads();
}
struct Moe1Sched {
    const LAS int* tab; const int* list; const char* H; const char* W; int G, c;
    __device__ __forceinline__ bool next(int i, pg8::Unit& u) const {
        const int MT = tab[32 + NBUCKET], U = MT * 8; const long L = (long)i * G + c; if (L >= U) return false;
        const int wgid = (int)(L % 8) * MT + (int)(L / 8);
        const int mtg = wgid >> 3, nt = wgid & 7; int b = 0;
#pragma unroll 1
        for (int k = 1; k < NBUCKET; ++k) b = (tab[32 + k] <= mtg) ? k : b;
        const int g = b / 6; int lo, hi; pair_of(b % 6, lo, hi);
        const int e = g * 4 + ((nt >> 2) ? hi : lo), fb = nt & 3;
        u.pm = mtg; u.pn = nt; u.a = H; u.b = W + ((size_t)e * 1024 + fb * 256) * 1024 * 2; u.jt = 1 << 30; u.jb = 0; u.aux0 = b; u.aux1 = mtg - tab[32 + b]; return true;
    }
    __device__ __forceinline__ unsigned arow(const pg8::Unit& u, int r) const { const int idx = u.aux1 * 256 + r, c = tab[u.aux0]; return (unsigned)list[u.aux0 * 16384 + (idx < c ? idx : 0)]; }
};
struct Moe2Sched {
    const LAS int* tab; const char* HID; const char* W; int G, c;
    __device__ __forceinline__ bool next(int i, pg8::Unit& u) const {
        const int MT = tab[32 + NBUCKET], U = MT * 4; const long L = (long)i * G + c; if (L >= U) return false;
        int wgid = (int)L; { const int q = U / 8, r = U % 8, xcd = wgid % 8, off = wgid / 8; wgid = (xcd < r ? xcd * (q + 1) : r * (q + 1) + (xcd - r) * q) + off; }
        const int mtg = wgid >> 2, nt = wgid & 3; int b = 0;
#pragma unroll 1
        for (int k = 1; k < NBUCKET; ++k) b = (tab[32 + k] <= mtg) ? k : b;
        const int g = b / 6; int lo, hi; pair_of(b % 6, lo, hi);
        u.pm = mtg; u.pn = nt; u.a = HID + (size_t)mtg * 256 * 1024 * 2; u.b = W + (((size_t)g * 1024 + nt * 256) * 2048 + lo * 512) * 2; u.jt = 8; u.jb = (hi - lo - 1) * 512 * 2; u.aux0 = b; u.aux1 = mtg - tab[32 + b]; return true;
    }
    __device__ __forceinline__ unsigned arow(const pg8::Unit&, int) const { return 0u; }
};
struct EpiSwiGLU {
    static constexpr bool PERM = true;
    bf16_t* hid; const LAS int* tab; const int* list; const float* rw;
    __device__ __forceinline__ void operator()(const f32x4 (&acc)[2][2][4][2], const pg8::Unit& u, int wr, int wc, int fr, int fq) const {
        const int slot = u.pn >> 2, fb = u.pn & 3, cnt = tab[u.aux0]; const int* lb = list + u.aux0 * 16384;
        int tok[8]; float w[8];
#pragma unroll
        for (int k = 0; k < 8; ++k) { const int r = (k >> 2) * 128 + wr * 64 + (k & 3) * 16 + fr, idx = u.aux1 * 256 + r; tok[k] = lb[idx < cnt ? idx : 0]; }
#pragma unroll
        for (int k = 0; k < 8; ++k) { const int r = (k >> 2) * 128 + wr * 64 + (k & 3) * 16 + fr, idx = u.aux1 * 256 + r; const float wv = rw[tok[k] * 2 + slot]; w[k] = idx < cnt ? wv : 0.f; }
#pragma unroll
        for (int ai = 0; ai < 2; ++ai)
#pragma unroll
            for (int m = 0; m < 4; ++m) { const int r = ai * 128 + wr * 64 + m * 16 + fr; const float wk = w[ai * 4 + m];
                float o[8];
#pragma unroll
                for (int n = 0; n < 2; ++n)
#pragma unroll
                    for (int j = 0; j < 4; ++j) { const float gt = acc[ai][0][m][n][j], up = acc[ai][1][m][n][j]; o[n * 4 + j] = gt * __builtin_amdgcn_rcpf(1.f + __builtin_amdgcn_exp2f(-gt * LOG2E)) * up * wk; }
                u32x4 v; v.x = cvt_pk_bf16(o[0], o[1]); v.y = cvt_pk_bf16(o[2], o[3]); v.z = cvt_pk_bf16(o[4], o[5]); v.w = cvt_pk_bf16(o[6], o[7]);
                *(u32x4*)(hid + (size_t)(u.pm * 256 + r) * 1024 + slot * 512 + fb * 128 + wc * 32 + 8 * fq) = v; }
    }
};
struct EpiMoe2 {
    static constexpr bool PERM = false;
    float* x; const LAS int* tab; const int* list; const float* gate; int g_off;
    __device__ __forceinline__ void operator()(const f32x4 (&acc)[2][2][4][2], const pg8::Unit& u, int wr, int wc, int fr, int fq) const {
        const int cnt = tab[u.aux0], col0 = u.pn * 256 + wc * 32 + 4 * fq; const int* lb = list + u.aux0 * 16384;
        int tok[8];
#pragma unroll
        for (int k = 0; k < 8; ++k) { const int r = (k >> 2) * 128 + wr * 64 + (k & 3) * 16 + fr, idx = u.aux1 * 256 + r; tok[k] = lb[idx < cnt ? idx : 0]; }
        const float* g0 = gate + g_off + col0;
        f32x4 gv[2][2][2];
#pragma unroll
        for (int b = 0; b < 2; ++b)
#pragma unroll
            for (int bj = 0; bj < 2; ++bj)
#pragma unroll
                for (int n = 0; n < 2; ++n) gv[b][bj][n] = *(const f32x4*)(g0 + b * 6144 + bj * 128 + n * 16);
#pragma unroll
        for (int pr = 0; pr < 4; ++pr) {
            f32x4 xv[2][2][2];
#pragma unroll
            for (int q = 0; q < 2; ++q) { const float* xr = x + (size_t)tok[pr * 2 + q] * DM + col0;
#pragma unroll
                for (int bj = 0; bj < 2; ++bj)
#pragma unroll
                    for (int n = 0; n < 2; ++n) xv[q][bj][n] = *(const f32x4*)(xr + bj * 128 + n * 16); }
#pragma unroll
            for (int q = 0; q < 2; ++q) { const int k = pr * 2 + q, ai = k >> 2, m = k & 3, r = ai * 128 + wr * 64 + m * 16 + fr, idx = u.aux1 * 256 + r; const bool b1 = tok[k] >= SEQ; float* xr = x + (size_t)tok[k] * DM + col0;
                if (idx < cnt) {
#pragma unroll
                    for (int bj = 0; bj < 2; ++bj)
#pragma unroll
                        for (int n = 0; n < 2; ++n) { const f32x4 g = b1 ? gv[1][bj][n] : gv[0][bj][n]; *(f32x4*)(xr + bj * 128 + n * 16) = xv[q][bj][n] + g * acc[ai][bj][m][n]; } } }
        }
    }
};

namespace attn {
constexpr int QBLK = 32, KVBLK = 64, LD = 1024;
constexpr int SHM_V = KVBLK * DV * 2, SHM_K = KVBLK * DH * 2;
constexpr int SHM_A = KVBLK * 16;
constexpr int LDS_TOTAL = 2 * SHM_V + 2 * SHM_K + NWAVES * 64 * 4;
constexpr float THR = 11.5f;
#define AT_KSWZ(row, colB) ((row) * 128 + ((colB) ^ ((((row) >> 1) & 7) << 4)))
#define AT_SBAR() __builtin_amdgcn_sched_barrier(0)
__device__ __forceinline__ int crow(int r, int hi) { return (r & 3) + 8 * (r >> 2) + 4 * hi; }
__device__ __forceinline__ void partialSM(f32x16& p0, f32x16& p1, float& m_reg, float& alpha, bool& moved) {
    float pmax = p0[0];
#pragma unroll
    for (int r = 1; r < 16; ++r) pmax = fmaxf(pmax, p0[r]);
#pragma unroll
    for (int r = 0; r < 16; ++r) pmax = fmaxf(pmax, p1[r]);
    { auto rr = __builtin_amdgcn_permlane32_swap(__float_as_uint(pmax), __float_as_uint(pmax), false, false); pmax = fmaxf(__uint_as_float(rr[0]), __uint_as_float(rr[1])); }
    if (__builtin_expect(__all(pmax <= THR), 1)) { alpha = 1.f; moved = false; }
    else { const float dl = fmaxf(pmax, 0.f); m_reg += dl; alpha = __builtin_amdgcn_exp2f(-dl); moved = true;
#pragma unroll
        for (int r = 0; r < 16; ++r) { p0[r] -= dl; p1[r] -= dl; } }
#pragma unroll
    for (int r = 0; r < 16; ++r) p0[r] = __builtin_amdgcn_exp2f(p0[r]);
}
__device__ __forceinline__ void finishSM(f32x16& p0, f32x16& p1, float alpha, float& l_reg, bf16x8& pa0, bf16x8& pa1, bf16x8& pa2, bf16x8& pa3) {
#pragma unroll
    for (int r = 0; r < 16; ++r) p1[r] = __builtin_amdgcn_exp2f(p1[r]);
    float ps = 0;
#pragma unroll
    for (int r = 0; r < 16; ++r) ps += p0[r];
#pragma unroll
    for (int r = 0; r < 16; ++r) ps += p1[r];
    { auto rr = __builtin_amdgcn_permlane32_swap(__float_as_uint(ps), __float_as_uint(ps), false, false); ps = __uint_as_float(rr[0]) + __uint_as_float(rr[1]); }
    l_reg = l_reg * alpha + ps;
#define AT_PK4(P, BASE, OUT) do { unsigned a0 = cvt_pk_bf16(P[BASE + 0], P[BASE + 1]), a1 = cvt_pk_bf16(P[BASE + 2], P[BASE + 3]);   \
    unsigned b0 = cvt_pk_bf16(P[BASE + 4], P[BASE + 5]), b1 = cvt_pk_bf16(P[BASE + 6], P[BASE + 7]);                              \
    auto r0 = __builtin_amdgcn_permlane32_swap(a0, b0, false, false); auto r1 = __builtin_amdgcn_permlane32_swap(a1, b1, false, false); \
    u32x4 w = {r0[0], r1[0], r0[1], r1[1]}; OUT = __builtin_bit_cast(bf16x8, w); } while (0)
    AT_PK4(p0, 0, pa0); AT_PK4(p0, 8, pa1); AT_PK4(p1, 0, pa2); AT_PK4(p1, 8, pa3);
#undef AT_PK4
}
__device__ __forceinline__ void split3(float x, unsigned& b1, unsigned& b2, unsigned& b3) {
    b1 = cvt_pk_bf16(x, 0.f) & 0xffffu; const float r1 = x - __builtin_bit_cast(float, b1 << 16); b2 = cvt_pk_bf16(r1, 0.f) & 0xffffu; const float r2 = r1 - __builtin_bit_cast(float, b2 << 16); b3 = cvt_pk_bf16(r2, 0.f) & 0xffffu;
}
__device__ __forceinline__ bf16x8 build_qa(float a, unsigned coef  , int hi) {
    unsigned a1, a2, a3; split3(a, a1, a2, a3);
    u32x4 w; w.x = a1 | (a2 << 16); w.y = a3 | (coef << 16); w.z = coef | (coef << 16); w.w = 0u;
    if (hi) w = (u32x4){0u, 0u, 0u, 0u};
    return __builtin_bit_cast(bf16x8, w);
}
__device__ __forceinline__ void qkt(f32x16& p0, f32x16& p1, const LAS char* Ks, const bf16x8* qr, bf16x8 qa, bf16x8 ka0, bf16x8 ka1, int r32, int hi) {
    p0 = f32x16{}; p1 = f32x16{};
#pragma unroll
    for (int d0 = 0; d0 < 4; ++d0) { const int cb = (d0 * 16 + hi * 8) * 2;
        const bf16x8 b0 = *(const LAS bf16x8*)(Ks + AT_KSWZ(r32, cb));
        const bf16x8 b1 = *(const LAS bf16x8*)(Ks + AT_KSWZ(32 + r32, cb));
        p0 = __builtin_amdgcn_mfma_f32_32x32x16_bf16(b0, qr[d0], p0, 0, 0, 0);
        p1 = __builtin_amdgcn_mfma_f32_32x32x16_bf16(b1, qr[d0], p1, 0, 0, 0); }
    p0 = __builtin_amdgcn_mfma_f32_32x32x16_bf16(ka0, qa, p0, 0, 0, 0);
    p1 = __builtin_amdgcn_mfma_f32_32x32x16_bf16(ka1, qa, p1, 0, 0, 0);
}
__device__ __forceinline__ void add_abs_bias(f32x16& p0, f32x16& p1, float dpos  , float nslope) {
#pragma unroll
    for (int r = 0; r < 16; ++r) { const float c = (float)((r & 3) + 8 * (r >> 2)); p0[r] = fmaf(nslope, fabsf(dpos - c), p0[r]); p1[r] = fmaf(nslope, fabsf(dpos - (c + 32.f)), p1[r]); }
}
__device__ __forceinline__ int v_st(int k, int c) { const int kk = (k & ~0xC) | ((k & 4) << 1) | ((k & 8) >> 1); return ((kk >> 3) * 4 + (c >> 5)) * 512 + ((kk & 7) * 32 + (c & 31)) * 2; }
__device__ __forceinline__ int v_rd_base(int lane) { return ((lane & 3) << 3) | (((lane >> 2) & 3) << 6) | (((lane >> 4) & 1) << 5) | (((lane >> 5) & 1) << 8); }
constexpr int v_rd_off(int d0, int ks, int half) { return d0 * 512 + ks * 4096 + half * 2048; }
template <int OFF> __device__ __forceinline__ s16x4 tr_read(int vb) { s16x4 r; asm volatile("ds_read_b64_tr_b16 %0, %1 offset:%2" : "=&v"(r) : "v"(vb), "i"(OFF) : "memory"); return r; }
template <int D0> __device__ __forceinline__ void pv_one(f32x16& od, int vb, bf16x8 pa0, bf16x8 pa1, bf16x8 pa2, bf16x8 pa3) {
    const s16x4 l0 = tr_read<v_rd_off(D0, 0, 0)>(vb), h0 = tr_read<v_rd_off(D0, 0, 1)>(vb), l1 = tr_read<v_rd_off(D0, 1, 0)>(vb), h1 = tr_read<v_rd_off(D0, 1, 1)>(vb);
    const s16x4 l2 = tr_read<v_rd_off(D0, 2, 0)>(vb), h2 = tr_read<v_rd_off(D0, 2, 1)>(vb), l3 = tr_read<v_rd_off(D0, 3, 0)>(vb), h3 = tr_read<v_rd_off(D0, 3, 1)>(vb);
    asm volatile("s_waitcnt lgkmcnt(0)" ::: "memory"); AT_SBAR();
#define AT_PK(L, H) (bf16x8){L[0], L[1], L[2], L[3], H[0], H[1], H[2], H[3]}
    od = __builtin_amdgcn_mfma_f32_32x32x16_bf16(pa0, AT_PK(l0, h0), od, 0, 0, 0);
    od = __builtin_amdgcn_mfma_f32_32x32x16_bf16(pa1, AT_PK(l1, h1), od, 0, 0, 0);
    od = __builtin_amdgcn_mfma_f32_32x32x16_bf16(pa2, AT_PK(l2, h2), od, 0, 0, 0);
    od = __builtin_amdgcn_mfma_f32_32x32x16_bf16(pa3, AT_PK(l3, h3), od, 0, 0, 0);
#undef AT_PK
}
__device__ __forceinline__ void pv_d0(f32x16* o, int vb, bf16x8 pa0, bf16x8 pa1, bf16x8 pa2, bf16x8 pa3) {
    pv_one<0>(o[0], vb, pa0, pa1, pa2, pa3); pv_one<1>(o[1], vb, pa0, pa1, pa2, pa3); pv_one<2>(o[2], vb, pa0, pa1, pa2, pa3); pv_one<3>(o[3], vb, pa0, pa1, pa2, pa3);
}
__device__ __forceinline__ void unit(const bf16_t* __restrict__ Qh, const bf16_t* __restrict__ Kh, const bf16_t* __restrict__ Vh, bf16_t* __restrict__ Oh, int q0, float slope2, int tlo, int NT  , LAS char* lds) {
    int tid = threadIdx.x; asm volatile("" : "+v"(tid));
    const int wid = __builtin_amdgcn_readfirstlane(tid >> 6), lane = tid & 63, r32 = lane & 31, hi = lane >> 5;
    LAS char* V_lds = lds; LAS char* K_lds = lds + 2 * SHM_V;
    LAS float* ws = (LAS float*)(lds + 2 * SHM_V + 2 * SHM_K) + wid * 64; LAS float* li_l = ws; LAS float* al_l = ws + 32;
    float m_reg = 0.f, l_reg = 0; f32x16 o[4] = {}; bf16x8 qr[4];
    const bf16_t* Qw = Qh + (size_t)(q0 + wid * QBLK + r32) * LD + hi * 8;
#pragma unroll
    for (int d0 = 0; d0 < 4; ++d0) qr[d0] = *(const bf16x8*)(Qw + d0 * 16);
    const float ipos = (float)(q0 + wid * QBLK + r32), qpos = ipos - 4.f * (float)hi;
    const int tdiag = (q0 + wid * QBLK) >> 6;
    bf16x8 ka0, ka1;
    { unsigned w1, w2, w3; split3(slope2 * (float)r32, w1, w2, w3); u32x4 w; w.x = 0x3f803f80u; w.y = 0x3f80u | (w1 << 16); w.z = w2 | (w3 << 16); w.w = 0u; ka0 = __builtin_bit_cast(bf16x8, w);
      split3(slope2 * (float)(32 + r32), w1, w2, w3); w.y = 0x3f80u | (w1 << 16); w.z = w2 | (w3 << 16); ka1 = __builtin_bit_cast(bf16x8, w); }
    const int sr = tid >> 4, sc = (tid & 15) * 8, vst0 = v_st(sr, sc), vst1 = v_st(32 + sr, sc);
    const int kr = tid >> 3, kc = (tid & 7) * 8, kst = AT_KSWZ(kr, kc * 2);
    const int vb0 = (int)(uintptr_t)V_lds + v_rd_base(lane);
    struct { bf16x8 vs0, vs1, ks0; } sr_[2];
#define AT_SLOAD(i, k0) do { sr_[i].vs0 = *(const bf16x8*)(&Vh[(size_t)((k0) + sr) * LD + sc]); sr_[i].vs1 = *(const bf16x8*)(&Vh[(size_t)((k0) + 32 + sr) * LD + sc]); \
    sr_[i].ks0 = *(const bf16x8*)(&Kh[(size_t)((k0) + kr) * LD + kc]); } while (0)
#define AT_SWRITE(b, i) do { *(LAS bf16x8*)(V_lds + (b) * SHM_V + vst0) = sr_[i].vs0; *(LAS bf16x8*)(V_lds + (b) * SHM_V + vst1) = sr_[i].vs1; \
    *(LAS bf16x8*)(K_lds + (b) * SHM_K + kst) = sr_[i].ks0; } while (0)
#define AT_RESC(a, mv) do { if (mv) { if (hi == 0) al_l[r32] = (a); asm volatile("s_waitcnt lgkmcnt(0)" ::: "memory"); \
    _Pragma("unroll") for (int d = 0; d < 4; ++d) _Pragma("unroll") for (int r = 0; r < 16; ++r) o[d][r] *= al_l[crow(r, hi)]; } } while (0)
#define AT_QKT(P0, P1, b, t) do { const int t_ = (t); const float di_ = ipos - (float)(t_ * KVBLK); \
    const bf16x8 qa_ = build_qa(t_ < tdiag ? -m_reg - slope2 * di_ : (t_ > tdiag ? -m_reg + slope2 * di_ : -m_reg), t_ < tdiag ? 0x3f80u : (t_ > tdiag ? 0xbf80u : 0u), hi); \
    qkt(P0, P1, K_lds + (b) * SHM_K, qr, qa_, ka0, ka1, r32, hi); if (t_ == tdiag) add_abs_bias(P0, P1, qpos - (float)(t_ * KVBLK), -slope2); } while (0)
    f32x16 pA0, pA1, pB0, pB1; float alA, alB; bool mvA, mvB; bf16x8 pa0, pa1, pa2, pa3; const int kb0 = tlo * KVBLK;
    AT_SLOAD(0, kb0); asm volatile("s_waitcnt vmcnt(0)" ::: "memory"); AT_SWRITE(0, 0); __syncthreads();
    AT_QKT(pA0, pA1, 0, tlo); partialSM(pA0, pA1, m_reg, alA, mvA); AT_RESC(alA, mvA);
    AT_SLOAD(1, kb0 + KVBLK); AT_SLOAD(0, kb0 + 2 * KVBLK);
    AT_SWRITE(1, 1); __syncthreads();
    for (int j = 1; j + 1 < NT; j += 2) {
        AT_SBAR(); AT_QKT(pB0, pB1, 1, tlo + j);
        finishSM(pA0, pA1, alA, l_reg, pa0, pa1, pa2, pa3); AT_SBAR();
        AT_SLOAD(1, kb0 + (j + 2) * KVBLK); AT_SBAR();
        pv_d0(o, vb0, pa0, pa1, pa2, pa3); partialSM(pB0, pB1, m_reg, alB, mvB);
        __syncthreads(); AT_SWRITE(0, 0);
        AT_RESC(alB, mvB); __syncthreads();
        AT_SBAR(); AT_QKT(pA0, pA1, 0, tlo + j + 1);
        finishSM(pB0, pB1, alB, l_reg, pa0, pa1, pa2, pa3); AT_SBAR();
        if (j + 3 < NT) AT_SLOAD(0, kb0 + (j + 3) * KVBLK); AT_SBAR();
        pv_d0(o, vb0 + SHM_V, pa0, pa1, pa2, pa3); partialSM(pA0, pA1, m_reg, alA, mvA);
        __syncthreads(); AT_SWRITE(1, 1);
        AT_RESC(alA, mvA); __syncthreads();
    }
    AT_SBAR(); AT_QKT(pB0, pB1, 1, tlo + NT - 1);
    finishSM(pA0, pA1, alA, l_reg, pa0, pa1, pa2, pa3); AT_SBAR();
    pv_d0(o, vb0, pa0, pa1, pa2, pa3); partialSM(pB0, pB1, m_reg, alB, mvB);
    __syncthreads(); AT_RESC(alB, mvB);
    finishSM(pB0, pB1, alB, l_reg, pa0, pa1, pa2, pa3); AT_SBAR();
    pv_d0(o, vb0 + SHM_V, pa0, pa1, pa2, pa3);
    if (hi == 0) li_l[r32] = l_reg; asm volatile("s_waitcnt lgkmcnt(0)" ::: "memory");
    float rli[16];
#pragma unroll
    for (int r = 0; r < 16; ++r) rli[r] = __builtin_amdgcn_rcpf(li_l[crow(r, hi)]);
    bf16_t* Ow = Oh + (size_t)(q0 + wid * QBLK) * LD;
#pragma unroll
    for (int r = 0; r < 16; ++r) { const int orow = crow(r, hi);
#pragma unroll
        for (int d0 = 0; d0 < 4; ++d0) Ow[(size_t)orow * LD + d0 * 32 + r32] = (bf16_t)f2bf(o[d0][r] * rli[r]); }
    __syncthreads();
#undef AT_SLOAD
#undef AT_SWRITE
#undef AT_RESC
#undef AT_QKT
}
}

namespace attn3 {
constexpr int QBLK = 32, KVBLK = 64, LD = 1024;
constexpr int KSLOT = 8192, VSLOT = 16384;
constexpr int LDS_K = 0, LDS_V = 3 * KSLOT, LDS_WS = LDS_V + 3 * VSLOT, LDS_OST = LDS_WS + NWAVES * 64 * 4, LDS_TOTAL = LDS_OST + NWAVES * 4096;
constexpr float THR = 11.5f;
typedef __attribute__((address_space(3))) const char* lds_cptr;
typedef short v4i16_t __attribute__((ext_vector_type(4)));
#define A3_SBAR() __builtin_amdgcn_sched_barrier(0)
#define A3_PIN(x) asm volatile("" : "+v"(x))
__device__ __forceinline__ int crow(int r, int hi) { return (r & 3) + 8 * (r >> 2) + 4 * hi; }
__device__ __forceinline__ void glds16(const void* gsrc, unsigned lds_dst) { unsigned keep;
    asm volatile("s_mov_b32 %0, m0\n\ts_mov_b32 m0, %2\n\ts_nop 0\n\tglobal_load_lds_dwordx4 %1, off\n\ts_mov_b32 m0, %0" : "=&s"(keep) : "v"(gsrc), "s"(lds_dst) : "memory"); }
__device__ __forceinline__ s16x4 vtr(lds_cptr p) { return __builtin_bit_cast(s16x4, __builtin_amdgcn_ds_read_tr16_b64_v4i16((__attribute__((address_space(3))) v4i16_t*)p)); }
__device__ __forceinline__ unsigned cvtpk_s(float lo, float hi) { typedef float f2_t __attribute__((ext_vector_type(2))); typedef __bf16 b2_t __attribute__((ext_vector_type(2))); f2_t v = {lo, hi}; b2_t b = __builtin_convertvector(v, b2_t); return __builtin_bit_cast(unsigned, b); }
#define A3_WAIT_BAR(N) asm volatile("s_waitcnt vmcnt(" #N ") lgkmcnt(0)\n\ts_barrier" ::: "memory")
__device__ __forceinline__ void split3(float x, unsigned& b1, unsigned& b2, unsigned& b3) {
    b1 = cvtpk_s(x, 0.f) & 0xffffu; const float r1 = x - __builtin_bit_cast(float, b1 << 16); b2 = cvtpk_s(r1, 0.f) & 0xffffu; const float r2 = r1 - __builtin_bit_cast(float, b2 << 16); b3 = cvtpk_s(r2, 0.f) & 0xffffu;
}
__device__ __forceinline__ bf16x8 build_qa(float a, unsigned coef, int hi) {
    unsigned a1, a2, a3; split3(a, a1, a2, a3);
    u32x4 w; w.x = a1 | (a2 << 16); w.y = a3 | (coef << 16); w.z = coef | (coef << 16); w.w = 0u;
    if (hi) w = (u32x4){0u, 0u, 0u, 0u};
    return __builtin_bit_cast(bf16x8, w);
}
__device__ __forceinline__ void unit(const bf16_t* __restrict__ Qh, const bf16_t* __restrict__ Kh, const bf16_t* __restrict__ Vh, bf16_t* __restrict__ Oh, int q0, float slope2, int tlo, int NT  , LAS char* shm) {
    int tid = threadIdx.x; asm volatile("" : "+v"(tid));
    const int lane = tid & 63, r32 = lane & 31, hi = lane >> 5; const int wid = __builtin_amdgcn_readfirstlane(tid >> 6);
    const unsigned lds0 = (unsigned)(uintptr_t)shm;
    LAS float* wsf = (LAS float*)(shm + LDS_WS) + wid * 64;
    const bf16_t* Qw = Qh + (size_t)(q0 + wid * QBLK + r32) * LD + hi * 8;
    const bf16_t* ksrc = Kh + (size_t)(tlo * KVBLK + lane) * LD + wid * 8;
    const bf16_t* vsrc = Vh + (size_t)(tlo * KVBLK + 16 * (wid & 3) + (lane >> 2)) * LD + (wid >> 2) * 32 + (lane & 3) * 8;
    const unsigned kdst = lds0 + LDS_K + wid * 1024, vdst = lds0 + LDS_V + wid * 1024;
#define A3_DMA_K(tt, slot) glds16(ksrc + (size_t)(tt) * KVBLK * LD, (unsigned)__builtin_amdgcn_readfirstlane(kdst + (slot) * KSLOT))
#define A3_DMA_V(tt, slot) do { glds16(vsrc + (size_t)(tt) * KVBLK * LD, (unsigned)__builtin_amdgcn_readfirstlane(vdst + (slot) * VSLOT)); \
    glds16(vsrc + (size_t)(tt) * KVBLK * LD + 64, (unsigned)__builtin_amdgcn_readfirstlane(vdst + (slot) * VSLOT + 8192)); } while (0)
    const lds_cptr shm3 = (lds_cptr)shm; const lds_cptr kp0 = shm3 + LDS_K + hi * 1024 + r32 * 16;
    const lds_cptr vp0 = shm3 + LDS_V + ((lane >> 4) & 1) * 32 + (lane & 3) * 8 + (4 * hi + ((lane & 15) >> 2)) * 64;
    A3_DMA_K(0, 0); A3_DMA_V(0, 0); A3_DMA_K(1, 1);
    bf16x8 qr[4];
#pragma unroll
    for (int d0 = 0; d0 < 4; ++d0) qr[d0] = *(const bf16x8*)(Qw + d0 * 16);
    bf16x8 ka0, ka1;
    { unsigned w1, w2, w3; split3(slope2 * (float)r32, w1, w2, w3); u32x4 w; w.x = 0x3f803f80u; w.y = 0x3f80u | (w1 << 16); w.z = w2 | (w3 << 16); w.w = 0u; ka0 = __builtin_bit_cast(bf16x8, w);
      split3(slope2 * (float)(32 + r32), w1, w2, w3); w.y = 0x3f80u | (w1 << 16); w.z = w2 | (w3 << 16); ka1 = __builtin_bit_cast(bf16x8, w); }
    const float ipos = (float)(q0 + wid * QBLK + r32), qpos = ipos - 4.f * (float)hi;
    const int tdiag = (q0 + wid * QBLK) >> 6;
    float m_reg = 0.f, l_reg = 0.f; f32x16 o[4]; o[0] = f32x16{}; o[1] = f32x16{}; o[2] = f32x16{}; o[3] = f32x16{};
    bool resc = false;
    int sl_prev = 0, sl_cur = 0, sl_next = 1;
#define A3_ROT() do { sl_prev = sl_cur; sl_cur = sl_next; sl_next = (sl_next == 2) ? 0 : sl_next + 1; } while (0)
    bf16x8 kf[8]; s16x4 vlo[8], vhi[8]; u32x4 pw0, pw1, pw2, pw3, pn0, pn1, pn2, pn3; f32x16 C0, C1;
#define A3_KLOAD(slot) do { const lds_cptr kp_ = kp0 + (slot) * KSLOT; _Pragma("unroll") for (int j_ = 0; j_ < 4; ++j_) { \
    kf[2 * j_] = *(const __attribute__((address_space(3))) bf16x8*)(kp_ + j_ * 2048); kf[2 * j_ + 1] = *(const __attribute__((address_space(3))) bf16x8*)(kp_ + j_ * 2048 + 512); } } while (0)
#define A3_QA(t_) build_qa((t_) < tdiag ? -m_reg - slope2 * (ipos - (float)((t_) * KVBLK)) : ((t_) > tdiag ? -m_reg + slope2 * (ipos - (float)((t_) * KVBLK)) : -m_reg), (t_) < tdiag ? 0x3f80u : ((t_) > tdiag ? 0xbf80u : 0u), hi)
#define A3_VRD(i, k) do { vlo[k] = vtr(vp_ + (i) * 1024); vhi[k] = vtr(vp_ + (i) * 1024 + 512); } while (0)
#define A3_VFR(k) (bf16x8){vlo[k][0], vlo[k][1], vlo[k][2], vlo[k][3], vhi[k][0], vhi[k][1], vhi[k][2], vhi[k][3]}
#define A3_PAF(k) __builtin_bit_cast(bf16x8, pw##k)
#define A3_BIAS(t_) do { if ((t_) == tdiag) { const float dp_ = qpos - (float)((t_) * KVBLK); _Pragma("unroll") for (int r = 0; r < 16; ++r) { const float c_ = (float)((r & 3) + 8 * (r >> 2)); \
    C0[r] = fmaf(-slope2, fabsf(dp_ - c_), C0[r]); C1[r] = fmaf(-slope2, fabsf(dp_ - (c_ + 32.f)), C1[r]); } } } while (0)
#define A3_MX3(a, b, c) __builtin_fmaxf(__builtin_fmaxf((a), (b)), (c))
#define A3_ROWMAX(rm) do { float a_ = A3_MX3(C0[0], C0[1], C1[0]), b_ = A3_MX3(C0[2], C0[3], C1[1]); a_ = A3_MX3(a_, C1[2], C1[3]); \
    _Pragma("unroll") for (int r = 4; r < 16; r += 4) { a_ = A3_MX3(a_, C0[r], C0[r + 1]); b_ = A3_MX3(b_, C0[r + 2], C0[r + 3]); a_ = A3_MX3(a_, C1[r], C1[r + 1]); b_ = A3_MX3(b_, C1[r + 2], C1[r + 3]); } \
    rm = __builtin_fmaxf(a_, b_); { auto rr_ = __builtin_amdgcn_permlane32_swap(__float_as_uint(rm), __float_as_uint(rm), false, false); rm = __builtin_fmaxf(__uint_as_float(rr_[0]), __uint_as_float(rr_[1])); } } while (0)
#define A3_PHASEA(t_, VR) do { const bf16x8 qa_ = A3_QA(t_); const lds_cptr vp_ = vp0 + sl_prev * VSLOT; A3_SBAR(); \
    if (VR) A3_VRD(0, 0); C0 = __builtin_amdgcn_mfma_f32_32x32x16_bf16(kf[0], qr[0], f32x16{}, 0, 0, 0); A3_SBAR(); \
    if (VR) A3_VRD(1, 1); C1 = __builtin_amdgcn_mfma_f32_32x32x16_bf16(kf[1], qr[0], f32x16{}, 0, 0, 0); A3_SBAR(); \
    if (VR) A3_VRD(2, 2); C0 = __builtin_amdgcn_mfma_f32_32x32x16_bf16(kf[2], qr[1], C0, 0, 0, 0); A3_SBAR(); \
    if (VR) A3_VRD(3, 3); C1 = __builtin_amdgcn_mfma_f32_32x32x16_bf16(kf[3], qr[1], C1, 0, 0, 0); A3_SBAR(); \
    C0 = __builtin_amdgcn_mfma_f32_32x32x16_bf16(kf[4], qr[2], C0, 0, 0, 0); C1 = __builtin_amdgcn_mfma_f32_32x32x16_bf16(kf[5], qr[2], C1, 0, 0, 0); \
    C0 = __builtin_amdgcn_mfma_f32_32x32x16_bf16(kf[6], qr[3], C0, 0, 0, 0); C1 = __builtin_amdgcn_mfma_f32_32x32x16_bf16(kf[7], qr[3], C1, 0, 0, 0); \
    C0 = __builtin_amdgcn_mfma_f32_32x32x16_bf16(ka0, qa_, C0, 0, 0, 0); C1 = __builtin_amdgcn_mfma_f32_32x32x16_bf16(ka1, qa_, C1, 0, 0, 0); A3_SBAR(); } while (0)
#define A3_EXP2(X, B, PN, W) do { X[B] = __builtin_amdgcn_exp2f(X[B]); X[B + 1] = __builtin_amdgcn_exp2f(X[B + 1]); sacc += X[B] + X[B + 1]; PN[W] = cvtpk_s(X[B], X[B + 1]); } while (0)
#define A3_GAPB(D0, KS, VK, X, B, PN, W) do { o[D0] = __builtin_amdgcn_mfma_f32_32x32x16_bf16(A3_PAF(KS), A3_VFR(VK), o[D0], 0, 0, 0); A3_EXP2(X, B, PN, W); A3_PIN(sacc); A3_PIN(PN); A3_SBAR(); } while (0)
#define A3_PHASEB() do { const lds_cptr vp_ = vp0 + sl_prev * VSLOT; float sacc = 0.f; \
    A3_GAPB(0, 0, 0, C0, 0, pn0, 0); A3_VRD(4, 4); A3_SBAR(); A3_GAPB(0, 1, 1, C0, 2, pn0, 1); A3_VRD(5, 5); A3_SBAR(); A3_GAPB(0, 2, 2, C0, 4, pn0, 2); A3_VRD(6, 6); A3_SBAR(); A3_GAPB(0, 3, 3, C0, 6, pn0, 3); A3_VRD(7, 7); A3_SBAR(); \
    A3_GAPB(1, 0, 4, C0, 8, pn1, 0); A3_VRD(8, 0); A3_SBAR(); A3_GAPB(1, 1, 5, C0, 10, pn1, 1); A3_VRD(9, 1); A3_SBAR(); A3_GAPB(1, 2, 6, C0, 12, pn1, 2); A3_VRD(10, 2); A3_SBAR(); A3_GAPB(1, 3, 7, C0, 14, pn1, 3); A3_VRD(11, 3); A3_SBAR(); \
    A3_GAPB(2, 0, 0, C1, 0, pn2, 0); A3_VRD(12, 4); A3_SBAR(); A3_GAPB(2, 1, 1, C1, 2, pn2, 1); A3_VRD(13, 5); A3_SBAR(); A3_GAPB(2, 2, 2, C1, 4, pn2, 2); A3_VRD(14, 6); A3_SBAR(); A3_GAPB(2, 3, 3, C1, 6, pn2, 3); A3_VRD(15, 7); A3_SBAR(); \
    A3_GAPB(3, 0, 4, C1, 8, pn3, 0); A3_GAPB(3, 1, 5, C1, 10, pn3, 1); A3_GAPB(3, 2, 6, C1, 12, pn3, 2); A3_GAPB(3, 3, 7, C1, 14, pn3, 3); \
    l_reg += sacc; pw0 = pn0; pw1 = pn1; pw2 = pn2; pw3 = pn3; } while (0)
#define A3_RESC() do { if (resc) { asm volatile("s_waitcnt lgkmcnt(0)" ::: "memory"); \
    _Pragma("unroll") for (int d_ = 0; d_ < 4; ++d_) _Pragma("unroll") for (int r = 0; r < 16; ++r) o[d_][r] *= wsf[crow(r, hi)]; } } while (0)
#define A3_DECIDE() do { float rm; A3_ROWMAX(rm); resc = false; \
    if (__builtin_expect(__any(rm > THR), 0)) { const float dl = __builtin_fmaxf(rm, 0.f); m_reg += dl; \
        _Pragma("unroll") for (int r = 0; r < 16; ++r) { C0[r] -= dl; C1[r] -= dl; } \
        const float f = __builtin_amdgcn_exp2f(-dl); l_reg *= f; if (hi == 0) wsf[r32] = f; resc = true; } } while (0)
    A3_DMA_K(2, 2);
    A3_WAIT_BAR(4);
    A3_KLOAD(0);
    A3_PHASEA(tlo, false); A3_BIAS(tlo);
    { float rm; A3_ROWMAX(rm); m_reg = rm;
#pragma unroll
      for (int r = 0; r < 16; ++r) { C0[r] -= rm; C1[r] -= rm; }
      float sacc = 0.f;
#pragma unroll
      for (int w = 0; w < 4; ++w) { A3_EXP2(C0, 2 * w, pw0, w); A3_EXP2(C0, 8 + 2 * w, pw1, w); A3_EXP2(C1, 2 * w, pw2, w); A3_EXP2(C1, 8 + 2 * w, pw3, w); }
      l_reg = sacc; }
    A3_WAIT_BAR(0);
    A3_DMA_V(1, 1);
    A3_ROT();
#define A3_STEP(tt_, GK, GV) do { const int t_ = tlo + (tt_); if (GK) A3_DMA_K((tt_) + 2, sl_prev); if (GV) A3_DMA_V((tt_) + 1, sl_next); A3_KLOAD(sl_cur); A3_PHASEA(t_, true); \
    A3_BIAS(t_); A3_DECIDE(); A3_SBAR(); A3_PHASEB(); } while (0)
#define A3_ENDW(tt_) do { if ((tt_) + 2 < NT) { A3_WAIT_BAR(3); } else { A3_WAIT_BAR(0); } } while (0)
    int tt = 1;
    for (; tt + 3 < NT; ++tt) { A3_STEP(tt, true, true); A3_WAIT_BAR(3); A3_RESC(); A3_ROT(); }
    for (; tt + 1 < NT; ++tt) { A3_STEP(tt, (tt + 2 < NT), (tt + 1 < NT)); A3_ENDW(tt); A3_RESC(); A3_ROT(); }
    A3_STEP(NT - 1, false, false); A3_RESC();
    { const lds_cptr vp_ = vp0 + sl_cur * VSLOT;
#pragma unroll
      for (int d0 = 0; d0 < 4; ++d0) {
#pragma unroll
          for (int ks = 0; ks < 4; ++ks) A3_VRD(d0 * 4 + ks, ks);
          o[d0] = __builtin_amdgcn_mfma_f32_32x32x16_bf16(A3_PAF(0), A3_VFR(0), o[d0], 0, 0, 0); o[d0] = __builtin_amdgcn_mfma_f32_32x32x16_bf16(A3_PAF(1), A3_VFR(1), o[d0], 0, 0, 0);
          o[d0] = __builtin_amdgcn_mfma_f32_32x32x16_bf16(A3_PAF(2), A3_VFR(2), o[d0], 0, 0, 0); o[d0] = __builtin_amdgcn_mfma_f32_32x32x16_bf16(A3_PAF(3), A3_VFR(3), o[d0], 0, 0, 0); } }
    { auto rr = __builtin_amdgcn_permlane32_swap(__float_as_uint(l_reg), __float_as_uint(l_reg), false, false); l_reg = __uint_as_float(rr[0]) + __uint_as_float(rr[1]); }
    if (hi == 0) wsf[32 + r32] = l_reg; asm volatile("s_waitcnt lgkmcnt(0)" ::: "memory");
    float rli[16];
#pragma unroll
    for (int r = 0; r < 16; ++r) rli[r] = __builtin_amdgcn_rcpf(wsf[32 + crow(r, hi)]);
    bf16_t* Ow = Oh + (size_t)(q0 + wid * QBLK) * LD;
    LAS unsigned short* stg = (LAS unsigned short*)(shm + LDS_OST) + wid * 2048;
#pragma unroll
    for (int hf = 0; hf < 2; ++hf) {
#pragma unroll
        for (int r = 0; r < 16; ++r) { const int orow = crow(r, hi);
#pragma unroll
            for (int d1 = 0; d1 < 2; ++d1) stg[orow * 64 + d1 * 32 + r32] = (unsigned short)f2bf(o[hf * 2 + d1][r] * rli[r]); }
        asm volatile("s_waitcnt lgkmcnt(0)" ::: "memory");
#pragma unroll
        for (int i = 0; i < 4; ++i) { const int row = i * 8 + (lane >> 3), ch = lane & 7; const u32x4 v = *(const LAS u32x4*)(stg + row * 64 + ch * 8); *(u32x4*)(Ow + (size_t)row * LD + hf * 64 + ch * 8) = v; }
        asm volatile("s_waitcnt lgkmcnt(0)" ::: "memory");
    }
    asm volatile("s_waitcnt vmcnt(0) lgkmcnt(0)\n\ts_barrier" ::: "memory");
}
}

__device__ __forceinline__ void combine_pass(Frame& F, const Args& A, const bf16_t* o1, const bf16_t* o2, bf16_t* out) {
    const int gw = F.vcu * NWAVES + F.wave, NGW = F.G * NWAVES;
    const float d1 = wave_sum(A.in[I_LQ1][F.lane] * A.in[I_LK1][F.lane]), d2 = wave_sum(A.in[I_LQ2][F.lane] * A.in[I_LK2][F.lane]);
    const float lam_init = 0.8f - 0.6f * 1.0f;
    const float lam = __expf(d1) - __expf(d2) + lam_init;
    float gsub[16];
#pragma unroll
    for (int j = 0; j < 16; ++j) gsub[j] = A.in[I_SUBLN][(F.lane & 7) * 16 + j] * (1.0f - lam_init);
    for (int m = gw; m < TOK; m += NGW) {
        const u32x4* p1 = (const u32x4*)(o1 + (size_t)m * DM + F.lane * 16); const u32x4* p2 = (const u32x4*)(o2 + (size_t)m * DM + F.lane * 16);
        const u32x4 a0 = p1[0], a1 = p1[1], b0 = p2[0], b1 = p2[1];
        float v[16]; float s = 0.f;
#pragma unroll
        for (int j = 0; j < 4; ++j) {
            const unsigned ua = a0[j], ub = b0[j], uc = a1[j], ud = b1[j];
            v[2 * j]     = __builtin_bit_cast(float, ua << 16) - lam * __builtin_bit_cast(float, ub << 16);
            v[2 * j + 1] = __builtin_bit_cast(float, ua & 0xffff0000u) - lam * __builtin_bit_cast(float, ub & 0xffff0000u);
            v[8 + 2 * j]     = __builtin_bit_cast(float, uc << 16) - lam * __builtin_bit_cast(float, ud << 16);
            v[8 + 2 * j + 1] = __builtin_bit_cast(float, uc & 0xffff0000u) - lam * __builtin_bit_cast(float, ud & 0xffff0000u);
        }
#pragma unroll
        for (int j = 0; j < 16; ++j) s += v[j] * v[j];
        s = sum8(s);
        const float rstd = 1.0f / sqrtf(s * (1.0f / 128.0f) + EPS);
        u32x4 w0, w1;
        w0.x = pk2(v[0] * rstd * gsub[0], v[1] * rstd * gsub[1]); w0.y = pk2(v[2] * rstd * gsub[2], v[3] * rstd * gsub[3]); w0.z = pk2(v[4] * rstd * gsub[4], v[5] * rstd * gsub[5]); w0.w = pk2(v[6] * rstd * gsub[6], v[7] * rstd * gsub[7]);
        w1.x = pk2(v[8] * rstd * gsub[8], v[9] * rstd * gsub[9]); w1.y = pk2(v[10] * rstd * gsub[10], v[11] * rstd * gsub[11]); w1.z = pk2(v[12] * rstd * gsub[12], v[13] * rstd * gsub[13]); w1.w = pk2(v[14] * rstd * gsub[14], v[15] * rstd * gsub[15]);
        u32x4* po = (u32x4*)(out + (size_t)m * DM + F.lane * 16); po[0] = w0; po[1] = w1;
    }
}

__device__ __forceinline__ void router_pass(Frame& F, const Args& A, int layer, const float* x, bf16_t* outb, gu32* cntw, int* list, float* rw) {
    const int gw = F.vcu * NWAVES + F.wave, NGW = F.G * NWAVES;
    const float* g = A.in[I_NFFN] + layer * DM; const float* modl = (const float*)(F.ws + WS_MISC + MS_MOD) + (size_t)layer * 2 * 6144;
    const float* rgw = A.in[I_RGW] + (size_t)layer * DM * 4; const float* rgb = A.in[I_RGB] + layer * 4;
    const float* rew = A.in[I_REW] + (size_t)layer * DM * 16; const float* reb = A.in[I_REB] + layer * 16;
    LAS float* wg = (LAS float*)F.lds; LAS float* we = wg + 4096;
    for (int i = F.tid; i < 1024; i += NTHREADS) { *(LAS f32x4*)(wg + 4 * i) = *(const f32x4*)(rgw + 4 * i);
#pragma unroll
        for (int gg = 0; gg < 4; ++gg) *(LAS f32x4*)(we + (gg * 1024 + i) * 4) = *(const f32x4*)(rew + i * 16 + gg * 4); }
    __syncthreads();
    f32x4 gv[4];
#pragma unroll
    for (int j = 0; j < 4; ++j) gv[j] = *((const GAS f32x4*)g + F.lane + 64 * j);
    for (int m = gw; m < TOK; m += NGW) {
        f32x4 v[4]; ld_row(x + (size_t)m * DM, F.lane, v);
        const float rstd = row_rstd(v);
        const float* mb = modl + (size_t)(m >> 13) * 6144;
        GAS u32x2* o8 = (GAS u32x2*)(outb + (size_t)m * DM) + F.lane;
        float lg[4] = {0.f, 0.f, 0.f, 0.f};
#pragma unroll
        for (int j = 0; j < 4; ++j) { const f32x4 sh = *((const GAS f32x4*)(mb + 3072) + F.lane + 64 * j), sc = *((const GAS f32x4*)(mb + 4096) + F.lane + 64 * j);
            v[j] = v[j] * rstd * gv[j] * (sc + 1.0f) + sh; u32x2 w; w.x = pk2(v[j].x, v[j].y); w.y = pk2(v[j].z, v[j].w); o8[64 * j] = w;
            const LAS f32x4* wr = (const LAS f32x4*)wg + (4 * F.lane + 256 * j);
#pragma unroll
            for (int e = 0; e < 4; ++e) { const f32x4 w4 = wr[e]; lg[0] += v[j][e] * w4.x; lg[1] += v[j][e] * w4.y; lg[2] += v[j][e] * w4.z; lg[3] += v[j][e] * w4.w; } }
#pragma unroll
        for (int e = 0; e < 4; ++e) lg[e] = wave_sum(lg[e]) + rgb[e];
        int gi = 0; float gm = lg[0];
#pragma unroll
        for (int e = 1; e < 4; ++e) if (lg[e] > gm) { gm = lg[e]; gi = e; }
        float gden = 0.f;
#pragma unroll
        for (int e = 0; e < 4; ++e) gden += __expf(lg[e] - gm);
        const float gprob = 1.0f / gden;
        gi = __builtin_amdgcn_readfirstlane(gi);
        float le[4] = {0.f, 0.f, 0.f, 0.f};
#pragma unroll
        for (int j = 0; j < 4; ++j) { const LAS f32x4* wr = (const LAS f32x4*)we + gi * 1024 + (4 * F.lane + 256 * j);
#pragma unroll
            for (int e = 0; e < 4; ++e) { const f32x4 w4 = wr[e]; le[0] += v[j][e] * w4.x; le[1] += v[j][e] * w4.y; le[2] += v[j][e] * w4.z; le[3] += v[j][e] * w4.w; } }
#pragma unroll
        for (int e = 0; e < 4; ++e) le[e] = wave_sum(le[e]) + reb[gi * 4 + e];
        int i1 = 0; float v1 = le[0];
#pragma unroll
        for (int e = 1; e < 4; ++e) if (le[e] > v1) { v1 = le[e]; i1 = e; }
        int i2 = -1; float v2 = -3.0e38f;
#pragma unroll
        for (int e = 0; e < 4; ++e) if (e != i1 && le[e] > v2) { v2 = le[e]; i2 = e; }
        const float w1 = 1.0f / (1.0f + __expf(v2 - v1)), w2 = 1.0f - w1;
        const int lo = i1 < i2 ? i1 : i2, hi = i1 < i2 ? i2 : i1;
        const float wlo = (i1 < i2 ? w1 : w2) * gprob, whi = (i1 < i2 ? w2 : w1) * gprob;
        const int pid = lo == 0 ? hi - 1 : (lo == 1 ? hi + 1 : 5);
        const int bkt = gi * 6 + pid;
        if (F.lane == 0) { const unsigned pos = __hip_atomic_fetch_add(cntw + 64 * bkt, 1u, RLX_AGENT); list[bkt * 16384 + pos] = m; rw[m * 2] = wlo; rw[m * 2 + 1] = whi; }
    }
}

#define FFT_DFT4(ar, ai, br, bi, cr, ci, dr, di) do { const float s0r = ar + cr, s0i = ai + ci, d0r = ar - cr, d0i = ai - ci, s1r = br + dr, s1i = bi + di, d1r = br - dr, d1i = bi - di; \
    ar = s0r + s1r; ai = s0i + s1i; cr = s0r - s1r; ci = s0i - s1i; br = d0r + d1i; bi = d0i - d1r; dr = d0r - d1i; di = d0i + d1r; } while (0)
#define FFT_TW(xr_, xi_, c_, s_) do { const float tr_ = xr_ * (c_) + xi_ * (s_), ti_ = xi_ * (c_) - xr_ * (s_); xr_ = tr_; xi_ = ti_; } while (0)
__device__ __forceinline__ void dft16(float (&xr)[16], float (&xi)[16]) {
#pragma unroll
    for (int n2 = 0; n2 < 4; ++n2) FFT_DFT4(xr[n2], xi[n2], xr[4 + n2], xi[4 + n2], xr[8 + n2], xi[8 + n2], xr[12 + n2], xi[12 + n2]);
    FFT_TW(xr[5], xi[5], 0.92387953251128674f, 0.38268343236508977f);
    FFT_TW(xr[6], xi[6], 0.70710678118654752f, 0.70710678118654752f);
    FFT_TW(xr[7], xi[7], 0.38268343236508977f, 0.92387953251128674f);
    FFT_TW(xr[9], xi[9], 0.70710678118654752f, 0.70710678118654752f);
    { const float tr_ = xi[10], ti_ = -xr[10]; xr[10] = tr_; xi[10] = ti_; }
    FFT_TW(xr[11], xi[11], -0.70710678118654752f, 0.70710678118654752f);
    FFT_TW(xr[13], xi[13], 0.38268343236508977f, 0.92387953251128674f);
    FFT_TW(xr[14], xi[14], -0.70710678118654752f, 0.70710678118654752f);
    FFT_TW(xr[15], xi[15], -0.92387953251128674f, -0.38268343236508977f);
#pragma unroll
    for (int k1 = 0; k1 < 4; ++k1) FFT_DFT4(xr[4 * k1], xi[4 * k1], xr[4 * k1 + 1], xi[4 * k1 + 1], xr[4 * k1 + 2], xi[4 * k1 + 2], xr[4 * k1 + 3], xi[4 * k1 + 3]);
}
#define FFT_DR(k) (4 * ((k) & 3) + ((k) >> 2))
__device__ __forceinline__ void fft_phase(Frame& F, const bf16_t* zT, bf16_t* fT) {
    LAS float* Gr = (LAS float*)F.lds; LAS float* Gi = Gr + 8704; LAS float* outb = Gi + 8704;
    const float* tw = (const float*)(F.ws + WS_MISC + MS_TW);
    const int tid = F.tid;
    const int q2 = tid & 15, t1 = tid >> 4;
    const int q3 = tid & 15, v3 = (tid >> 4) & 1, p3 = tid >> 5;
    float w1r[16], w1i[16], w2r[16], w2i[16], w3r[16], w3i[16];
#pragma unroll
    for (int q = 0; q < 16; ++q) { const int i1 = tid * q, i2 = 16 * t1 * q, i3 = 256 * q;
        w1r[q] = tw[i1]; w1i[q] = tw[8192 + i1]; w2r[q] = tw[i2]; w2i[q] = tw[8192 + i2]; w3r[q] = v3 ? tw[i3] : 1.f; w3i[q] = v3 ? tw[8192 + i3] : 0.f; }
    for (int job = F.vcu; job < 2048; job += F.G) {
        const int l = job >> 1, b = job & 1;
        const bf16_t* uc = zT + (size_t)l * TOK + b * SEQ; const bf16_t* us = zT + (size_t)(1024 + l) * TOK + b * SEQ;
        float xr[16], xi[16];
#pragma unroll
        for (int k = 0; k < 16; ++k) { xr[k] = bf2f(uc[tid + 512 * k]); xi[k] = -bf2f(us[tid + 512 * k]); }
        dft16(xr, xi);
#pragma unroll
        for (int q = 0; q < 16; ++q) { float a = xr[FFT_DR(q)], c = xi[FFT_DR(q)]; FFT_TW(a, c, w1r[q], w1i[q]); Gr[tid * 17 + q] = a; Gi[tid * 17 + q] = c; }
        __syncthreads();
#pragma unroll
        for (int t2 = 0; t2 < 16; ++t2) { xr[t2] = Gr[(t1 + 32 * t2) * 17 + q2]; xi[t2] = Gi[(t1 + 32 * t2) * 17 + q2]; }
        dft16(xr, xi);
        __syncthreads();
#pragma unroll
        for (int p = 0; p < 16; ++p) { float a = xr[FFT_DR(p)], c = xi[FFT_DR(p)]; FFT_TW(a, c, w2r[p], w2i[p]); Gr[p * 512 + tid] = a; Gi[p * 512 + tid] = c; }
        __syncthreads();
#pragma unroll
        for (int u = 0; u < 16; ++u) { xr[u] = Gr[p3 * 512 + (2 * u + v3) * 16 + q3]; xi[u] = Gi[p3 * 512 + (2 * u + v3) * 16 + q3]; }
        dft16(xr, xi);
#pragma unroll
        for (int r3 = 0; r3 < 16; ++r3) { const float a = xr[FFT_DR(r3)], c = xi[FFT_DR(r3)]; const float dr = a * w3r[r3] + c * w3i[r3];
            const float pr = __shfl_xor(dr, 16); const float y = v3 ? pr - dr : dr + pr;
            outb[q3 + 16 * p3 + 256 * r3 + 4096 * v3] = y; }
        __syncthreads();
        bf16_t* o = fT + (size_t)l * TOK + b * SEQ;
#pragma unroll
        for (int it = 0; it < 2; ++it) { const int k0 = 8 * (tid + NTHREADS * it); const f32x4 r0 = *(const LAS f32x4*)(outb + k0), r1 = *(const LAS f32x4*)(outb + k0 + 4); const float sc = 0.011048543456039806f;
            u32x4 w; w.x = pk2(r0.x * sc, r0.y * sc); w.y = pk2(r0.z * sc, r0.w * sc); w.z = pk2(r1.x * sc, r1.y * sc); w.w = pk2(r1.z * sc, r1.w * sc); *(u32x4*)(o + k0) = w; }
    }
    __syncthreads();
}
__device__ __forceinline__ void transpose_phase(Frame& F, const bf16_t* fT, bf16_t* f) {
    LAS unsigned short* tile = (LAS unsigned short*)(F.lds + F.wave * 12288);
    const int gw = F.vcu * NWAVES + F.wave, NGW = F.G * NWAVES;
    for (int t = gw; t < 16 * 256; t += NGW) { const int lb = t >> 8, tb = t & 255;
#pragma unroll
        for (int it = 0; it < 8; ++it) { const int r = it * 8 + (F.lane >> 3), ch = F.lane & 7; *(LAS u32x4*)(tile + r * 72 + ch * 8) = *(const u32x4*)(fT + (size_t)(lb * 64 + r) * TOK + tb * 64 + ch * 8); }
        LDS_WAIT(); asm volatile("" ::: "memory");
#pragma unroll
        for (int it = 0; it < 8; ++it) { const int tk = it * 8 + (F.lane >> 3), c = F.lane & 7; unsigned short e[8];
#pragma unroll
            for (int q = 0; q < 8; ++q) e[q] = tile[(8 * c + q) * 72 + tk];
            u32x4 w; w.x = e[0] | ((unsigned)e[1] << 16); w.y = e[2] | ((unsigned)e[3] << 16); w.z = e[4] | ((unsigned)e[5] << 16); w.w = e[6] | ((unsigned)e[7] << 16);
            *(u32x4*)(f + (size_t)(tb * 64 + tk) * DM + lb * 64 + c * 8) = w; }
        LDS_WAIT(); asm volatile("" ::: "memory");
    }
}

#ifndef MK_N_LAUNCHES
#define MK_N_LAUNCHES 1
#endif
constexpr int N_PHASES = 18;
__global__ void __launch_bounds__(NTHREADS, 2) mk_fwd(Args args) {
    extern __shared__ __attribute__((aligned(16))) unsigned char lds_raw[];
    Frame F;
    F.lds = (LAS unsigned char*)lds_raw;
    F.tid = threadIdx.x; F.lane = F.tid & 63; F.wave = __builtin_amdgcn_readfirstlane(F.tid >> 6);
    F.G = gridDim.x; { const int bx = blockIdx.x; F.vcu = (F.G % 8 == 0) ? (bx % 8) * (F.G / 8) + bx / 8 : bx; }
    F.ws = args.ws; F.ctl = (gu32*)(args.ws + WS_CTL);
    unsigned char* ws = args.ws;
    for (int u = F.tid; u < (LDS_BYTES - LDSCTL_OFF) / 4; u += NTHREADS) ((LAS unsigned*)(F.lds + LDSCTL_OFF))[u] = 0u;
    __syncthreads();
    volatile LAS unsigned* MISC = (volatile LAS unsigned*)(F.lds + MISC_OFF);
    LAS int* mtab = (LAS int*)(F.lds + RING_BYTES + 1024);
    XcdBarrier bar = xcd_barrier_post((unsigned*)(F.ctl + CW_BAR), MISC + 8);
    const int lo = args.ph_lo, hi = args.ph_hi;
#ifndef PH_MASK
#define PH_MASK 0x3ffff
#endif
#define IN(k) (((PH_MASK >> (k)) & 1) && lo <= (k) && (k) < hi)
#define SEAM(k) do { if (IN((k) + 1)) xcd_barrier(bar); } while (0)
    float* mod = (float*)(ws + WS_MISC + MS_MOD);
    float* X = (float*)(ws + WS_X); bf16_t* H = (bf16_t*)(ws + WS_H);
    bf16_t* Qb = (bf16_t*)(ws + WS_Q); bf16_t* Kb = (bf16_t*)(ws + WS_K); bf16_t* Vb = (bf16_t*)(ws + WS_V);
    bf16_t* ON = (bf16_t*)args.out;
    int* list = (int*)(ws + WS_LIST); float* rw = (float*)(ws + WS_MISC + MS_RW);
    bf16_t* HID = (bf16_t*)(ws + WS_HID); bf16_t* ZT = (bf16_t*)(ws + WS_ZT); bf16_t* FT = (bf16_t*)(ws + WS_FT);

#define REFRESH() do { int t_ = threadIdx.x; asm volatile("" : "+v"(t_)); F.tid = t_; F.lane = t_ & 63; } while (0)
#ifndef REPR
#define REPR 1
#endif
#ifndef REP8
#define REP8 1
#endif
#ifndef REP5
#define REP5 1
#endif
#ifndef REP10
#define REP10 1
#endif
#ifndef REPT
#define REPT 1
#endif
#ifndef REP0
#define REP0 1
#endif
#ifndef REP11
#define REP11 1
#endif
#ifndef REP2
#define REP2 1
#endif
#ifndef REP7
#define REP7 1
#endif
    if (IN(0)) { for (int rep = 0; rep < REP0; ++rep) { p0_prologue(F, args); __syncthreads(); } SEAM(0); }
    if (IN(1)) { REFRESH(); for (int rep = 0; rep < REPT; ++rep) norm_pass(F, args.in[I_X], args.in[I_NMIX], mod, 0, 1024, H, nullptr); SEAM(1); }
    if (IN(2)) { DenseSched S; S.init(H, ws + WS_WQKV, TOK, 3072, 1024, 1024, F.G, (int)blockIdx.x);
        EpiQKV E{Qb, (size_t)TOK * DM, 0.125f * LOG2E, (unsigned*)(F.ctl + CW_NMAX)};
        for (int rep = 0; rep < REP2; ++rep) pg8::gemm_phase<EpiQKV, DenseSched, false>(F.lds, 1024, 1024, 1024, S, E); SEAM(2); }
    if (IN(3)) {
        volatile LAS int* qslot = (volatile LAS int*)(F.lds + RING_BYTES + 2048);
#ifndef REP3
#define REP3 1
#endif
        for (int rep3 = 0; rep3 < REP3; ++rep3) {
        gu32* qhead = F.ctl + CW_QHEAD + 64 * rep3; const gu32* nmax = F.ctl + CW_NMAX;
        int idx = 0;
        if (F.tid == 0) qslot[0] = (int)__hip_atomic_fetch_add(qhead, 1u, RLX_AGENT);
        __syncthreads(); idx = __builtin_amdgcn_readfirstlane(qslot[0]); __syncthreads();
        while (idx < 1024) {
            if (F.tid == 0) qslot[0] = (int)__hip_atomic_fetch_add(qhead, 1u, RLX_AGENT);
            const int head = 7 - (idx >> 7), rem = idx & 127, b = rem >> 6, which = (rem >> 5) & 1, qb = rem & 31, h16 = head * 2 + which;
            const size_t rb = (size_t)b * SEQ * DM; const float slope2 = exp2f(-(float)(head + 1)) * LOG2E;
            const float q2 = __uint_as_float(__hip_atomic_load(nmax + ((0 * 2 + b) * 16 + h16) * 2, RLX_AGENT)) + __uint_as_float(__hip_atomic_load(nmax + ((0 * 2 + b) * 16 + h16) * 2 + 1, RLX_AGENT));
            const float k2 = __uint_as_float(__hip_atomic_load(nmax + ((1 * 2 + b) * 16 + h16) * 2, RLX_AGENT)) + __uint_as_float(__hip_atomic_load(nmax + ((1 * 2 + b) * 16 + h16) * 2 + 1, RLX_AGENT));
            const float reach = (2.0f * 1.02f * sqrtf(q2 * k2) + 152.0f) / slope2;
            const int dcut = reach < 16384.f ? (int)reach + 1 : 16384;
            int tlo = (qb * 256 - dcut) >> 6, thi = (qb * 256 + 255 + dcut) >> 6; tlo = tlo < 0 ? 0 : tlo; thi = thi > 127 ? 127 : thi;
            if (((thi - tlo + 1) & 1) != 0) { if (thi < 127) ++thi; else --tlo; }
            tlo = __builtin_amdgcn_readfirstlane(tlo); thi = __builtin_amdgcn_readfirstlane(thi);
            attn3::unit(Qb + rb + h16 * 64, Kb + rb + h16 * 64, Vb + rb + head * 128, ON + (size_t)which * TOK * DM + rb + head * 128, qb * 256, slope2, tlo, thi - tlo + 1, (LAS char*)F.lds);
            idx = __builtin_amdgcn_readfirstlane(qslot[0]); __syncthreads();
        }
        }
        SEAM(3); }
    if (IN(4)) { REFRESH(); for (int rep = 0; rep < REPT; ++rep) combine_pass(F, args, ON, ON + (size_t)TOK * DM, H); SEAM(4); }
    if (IN(5)) { DenseSched S; S.init(H, ws + WS_WO, TOK, 1024, 1024, 1024, F.G, (int)blockIdx.x);
        EpiRes E{args.in[I_X], X, mod, 2048};
        for (int rep = 0; rep < REP5; ++rep) pg8::gemm_phase<EpiRes, DenseSched, false>(F.lds, 1024, 1024, 1024, S, E); SEAM(5); }
#define MOE_LAYER(layer, pb) do { \
        gu32* cntw = F.ctl + CW_CNT + (layer) * NBUCKET * 64; \
        const float* modl = mod + (size_t)(layer) * 2 * 6144; \
        if (IN(pb)) { REFRESH(); for (int rep = 1; rep < REPR; ++rep) router_pass(F, args, (layer), X, H, F.ctl + 16384 + (layer) * NBUCKET * 64, (int*)args.out, (float*)args.out + 8 * 1024 * 1024); router_pass(F, args, (layer), X, H, cntw, list, rw); SEAM(pb); } \
        if (IN((pb) + 1)) { REFRESH(); moe_build_tab(F, cntw, mtab); \
            Moe1Sched S{mtab, list, (const char*)H, (const char*)(ws + WS_WGU) + (size_t)(layer) * 16 * 1024 * 1024 * 2, F.G, F.vcu}; \
            EpiSwiGLU E{HID, mtab, list, rw}; \
            for (int rep = 0; rep < REP7; ++rep) pg8::gemm_phase<EpiSwiGLU, Moe1Sched, true>(F.lds, 1024, 1024, 1024, S, E); SEAM((pb) + 1); } \
        if (IN((pb) + 2)) { REFRESH(); moe_build_tab(F, cntw, mtab); \
            Moe2Sched S{mtab, (const char*)HID, (const char*)(ws + WS_WD) + (size_t)(layer) * 4 * 1024 * 2048 * 2, F.G, F.vcu}; \
            EpiMoe2 E{X, mtab, list, modl, 5120}; EpiMoe2 E2{args.out, mtab, list, modl, 5120}; \
            for (int rep = 1; rep < REP8; ++rep) pg8::gemm_phase<EpiMoe2, Moe2Sched, false>(F.lds, 1024, 1024, 2048, S, E2); \
            pg8::gemm_phase<EpiMoe2, Moe2Sched, false>(F.lds, 1024, 1024, 2048, S, E); SEAM((pb) + 2); } } while (0)
    MOE_LAYER(0, 6);
    if (IN(9)) { REFRESH(); for (int rep = 0; rep < REPT; ++rep) norm_pass(F, X, args.in[I_NMIX] + DM, mod + 2 * 6144, 0, 1024, H, nullptr); SEAM(9); }
    if (IN(10)) { DenseSched S; S.init(ws + WS_WFI, H, 2048, TOK, 1024, 1024, F.G, (int)blockIdx.x);
        EpiBf16 E{ZT, TOK, 0, 0, 1.f};
        for (int rep = 0; rep < REP10; ++rep) pg8::gemm_phase<EpiBf16, DenseSched, false>(F.lds, 1024, 1024, 1024, S, E); SEAM(10); }
    if (IN(11)) { REFRESH(); for (int rep = 0; rep < REP11; ++rep) fft_phase(F, ZT, FT); SEAM(11); }
    if (IN(12)) { REFRESH(); for (int rep = 0; rep < REPT; ++rep) transpose_phase(F, FT, H); SEAM(12); }
    if (IN(13)) { DenseSched S; S.init(H, ws + WS_WFO, TOK, 1024, 1024, 1024, F.G, (int)blockIdx.x);
        EpiRes E{X, X, mod + 2 * 6144, 2048};
        pg8::gemm_phase<EpiRes, DenseSched, false>(F.lds, 1024, 1024, 1024, S, E); SEAM(13); }
    MOE_LAYER(1, 14);
    if (IN(17)) { REFRESH(); for (int rep = 0; rep < REPT; ++rep) norm_pass(F, X, args.in[I_NFIN], nullptr, 0, 0, nullptr, args.out); }
#undef IN
#undef SEAM
}

extern "C" void kernel_launch(void* const* d_in, const int* in_sizes, int n_in, void* d_out, int out_size, void* d_ws, size_t ws_size, hipStream_t stream) {
    static int ok = 0;
    if (ok == 0) {
        if (n_in != 23 || in_sizes[0] != TOK * DM || out_size != TOK * DM || ws_size < WS_END) { fprintf(stderr, "kernel_launch: unexpected shapes (n_in %d, in0 %d, out %d, ws %zu < %zu); nothing launched\n", n_in, n_in > 0 ? in_sizes[0] : -1, out_size, ws_size, (size_t)WS_END); ok = -1; return; }
        if (hipFuncSetAttribute((const void*)mk_fwd, hipFuncAttributeMaxDynamicSharedMemorySize, LDS_BYTES) != hipSuccess) { fprintf(stderr, "kernel_launch: hipFuncSetAttribute failed\n"); ok = -1; return; }
        ok = 1;
    }
    if (ok < 0) return;
    (void)hipMemsetAsync((char*)d_ws + WS_CTL, 0, CTL_ZERO_BYTES, stream);
    Args a{};
    for (int i = 0; i < 23; ++i) a.in[i] = (const float*)d_in[i];
    a.out = (float*)d_out; a.ws = (unsigned char*)d_ws;
#if MK_N_LAUNCHES == 1
    a.ph_lo = 0; a.ph_hi = N_PHASES;
    hipLaunchKernelGGL(mk_fwd, dim3(256), dim3(NTHREADS), LDS_BYTES, stream, a);
#else
    for (int p = 0; p < N_PHASES; ++p) { a.ph_lo = p; a.ph_hi = p + 1; hipLaunchKernelGGL(mk_fwd, dim3(256), dim3(NTHREADS), LDS_BYTES, stream, a); }
#endif
}
```
